# Optimizing an MI355X kernel written in HIP

```python
import math
import jax, jax.numpy as jnp
from jax import lax
import numpy as np

D_MODEL = 1024
BATCH = 8
SEQ = 4096
DEPTH = 4

EPS = 1e-6
HG_HEADS = 4
HG_DK = 128
HG_DV = 128
HG_WIDTH = HG_HEADS * HG_DV
HG_CHUNK = 64
MLA_HEADS = 8
MLA_NOPE = 64
MLA_ROPE = 32
MLA_V = 64
MLA_Q_LORA = 384
MLA_KV_LORA = 256
MLA_WIDTH = MLA_HEADS * MLA_V
ROPE_THETA = 10000.0
ATTN_BLOCK = 128
SSM_HEADS = 8
SSM_HEAD_DIM = 64
SSM_WIDTH = SSM_HEADS * SSM_HEAD_DIM
SSM_GROUPS = 2
SSM_HPG = SSM_HEADS // SSM_GROUPS
SSM_STATE = 64
SSM_CONV = 4
SSM_CHUNK = 128
SSM_CONV_DIM = SSM_WIDTH + 2 * SSM_GROUPS * SSM_STATE
D_FF = 4 * D_MODEL
N_BRANCH = 3
COL_SIZES = (HG_HEADS * HG_DK, HG_HEADS * HG_DK, HG_WIDTH, HG_WIDTH,
             MLA_Q_LORA, MLA_KV_LORA, MLA_ROPE,
             SSM_WIDTH, SSM_CONV_DIM, SSM_HEADS,
             N_BRANCH * D_MODEL)
IN_COLS = sum(COL_SIZES)

kernel_name = "hybrid_hgrn2_mla_mamba2_gated_block"


def rmsnorm(x, g):
    xf = x.astype(jnp.float32)
    y = xf * lax.rsqrt(jnp.mean(xf * xf, axis=-1, keepdims=True) + EPS)
    return (y * g.astype(jnp.float32)).astype(x.dtype)


def segsum(a):
    L = a.shape[-1]
    cs = jnp.cumsum(a, axis=-1)
    diff = cs[..., :, None] - cs[..., None, :]
    return jnp.where(jnp.tril(jnp.ones((L, L), bool)), diff, -jnp.inf)


def hgrn2_mixer(q, f, i, g, lb, norm_g):
    Bsz, T, _ = q.shape
    L = HG_CHUNK
    nC = T // L
    dt = q.dtype
    q = jax.nn.silu(q)
    ff = f.astype(jnp.float32)
    lb = lb.astype(jnp.float32)
    log_f = jnp.logaddexp(jnp.log(lb), jnp.log1p(-lb) + jax.nn.log_sigmoid(ff))
    k = (1.0 - lb) * jax.nn.sigmoid(-ff)

    def chunks(t, d):
        return t.reshape(Bsz, nC, L, HG_HEADS, d).transpose(1, 0, 3, 2, 4)

    qc = chunks(q, HG_DK)
    kc = chunks(k, HG_DK)
    vc = chunks(i, HG_DV)
    bc = jnp.cumsum(chunks(log_f, HG_DK), axis=3)
    causal = jnp.tril(jnp.ones((L, L), bool))[:, :, None]

    def step(S, inp):
        qk, kk, vk, bk = inp
        diff = bk[:, :, :, None, :] - bk[:, :, None, :, :]
        decay = jnp.exp(jnp.where(causal, diff, -jnp.inf))
        attn = jnp.einsum('bhik,bhijk,bhjk->bhij', qk, decay, kk)
        o = (jnp.einsum('bhij,bhjv->bhiv', attn, vk)
             + jnp.einsum('bhik,bhkv->bhiv', qk * jnp.exp(bk), S))
        blast = bk[:, :, -1:, :]
        S = (jnp.exp(blast[:, :, 0, :])[..., None] * S
             + jnp.einsum('bhjk,bhjv->bhkv', kk * jnp.exp(blast - bk), vk))
        return S, o.astype(jnp.float32)

    S0 = jnp.zeros((Bsz, HG_HEADS, HG_DK, HG_DV), jnp.float32)
    _, o = lax.scan(step, S0, (qc, kc, vc, bc))
    o = o.transpose(1, 0, 3, 2, 4).reshape(Bsz, T, HG_HEADS, HG_DV)
    o = rmsnorm(o, norm_g.reshape(HG_HEADS, HG_DV)).reshape(Bsz, T, HG_WIDTH)
    return (o * jax.nn.silu(g.astype(jnp.float32))).astype(dt)


def rope_cos_sin(pos):
    inv = ROPE_THETA ** (-jnp.arange(0, MLA_ROPE, 2, dtype=jnp.float32) / MLA_ROPE)
    ang = pos.astype(jnp.float32)[..., None] * inv
    return jnp.cos(ang), jnp.sin(ang)


def apply_rope(x, cos, sin):
    x1, x2 = jnp.split(x, 2, axis=-1)
    c = cos[:, :, None, :].astype(x.dtype)
    s = sin[:, :, None, :].astype(x.dtype)
    return jnp.concatenate([x1 * c - x2 * s, x2 * c + x1 * s], axis=-1)


def mla_mixer(cq, ckv, kr, positions, q_norm, kv_norm, w_uq, w_ukv):
    Bsz, T, _ = cq.shape
    cq = rmsnorm(cq, q_norm)
    ckv = rmsnorm(ckv, kv_norm)
    q = (cq @ w_uq).reshape(Bsz, T, MLA_HEADS, MLA_NOPE + MLA_ROPE)
    kv = (ckv @ w_ukv).reshape(Bsz, T, MLA_HEADS, MLA_NOPE + MLA_V)
    q_nope, q_rope = q[..., :MLA_NOPE], q[..., MLA_NOPE:]
    k_nope, v = kv[..., :MLA_NOPE], kv[..., MLA_NOPE:]
    cos, sin = rope_cos_sin(positions)
    q_rope = apply_rope(q_rope, cos, sin)
    k_rope = apply_rope(kr[:, :, None, :], cos, sin)[:, :, 0, :]
    scale = (MLA_NOPE + MLA_ROPE) ** -0.5
    nb = T // ATTN_BLOCK
    qn_b = q_nope.reshape(Bsz, nb, ATTN_BLOCK, MLA_HEADS, MLA_NOPE).transpose(1, 0, 2, 3, 4)
    qr_b = q_rope.reshape(Bsz, nb, ATTN_BLOCK, MLA_HEADS, MLA_ROPE).transpose(1, 0, 2, 3, 4)
    kpos = jnp.arange(T)

    def block(args):
        qn, qr, start = args
        s = (jnp.einsum('bqhd,bkhd->bhqk', qn, k_nope)
             + jnp.einsum('bqhr,bkr->bhqk', qr, k_rope)).astype(jnp.float32) * scale
        qpos = start + jnp.arange(ATTN_BLOCK)
        s = jnp.where(kpos[None, :] <= qpos[:, None], s, -jnp.inf)
        p = jax.nn.softmax(s, axis=-1)
        return jnp.einsum('bhqk,bkhd->bqhd', p.astype(v.dtype), v)

    o = lax.map(block, (qn_b, qr_b, jnp.arange(nb) * ATTN_BLOCK))
    return o.transpose(1, 0, 2, 3, 4).reshape(Bsz, T, MLA_WIDTH)


def mamba2_mixer(z, xbc, dt_raw, conv_w, conv_b, dt_bias, a_log, d_skip, norm_g):
    Bsz, T, _ = xbc.shape
    L = SSM_CHUNK
    c = T // L
    G, J, P, N = SSM_GROUPS, SSM_HPG, SSM_HEAD_DIM, SSM_STATE
    out_dtype = xbc.dtype
    xbc = lax.conv_general_dilated(xbc, conv_w[:, None, :], window_strides=(1,),
                                   padding=[(SSM_CONV - 1, 0)],
                                   dimension_numbers=('NWC', 'WIO', 'NWC'),
                                   feature_group_count=SSM_CONV_DIM)
    xbc = jax.nn.silu(xbc + conv_b)
    xs = xbc[..., :SSM_WIDTH].reshape(Bsz, T, G, J, P)
    Bm = xbc[..., SSM_WIDTH:SSM_WIDTH + G * N].reshape(Bsz, c, L, G, N)
    Cm = xbc[..., SSM_WIDTH + G * N:].reshape(Bsz, c, L, G, N)
    dt = jax.nn.softplus(dt_raw.astype(jnp.float32) + dt_bias.astype(jnp.float32))
    A = -jnp.exp(a_log.astype(jnp.float32))
    a = (dt * A).reshape(Bsz, c, L, G, J).transpose(0, 3, 4, 1, 2)
    X = (xs * dt.reshape(Bsz, T, G, J)[..., None]).reshape(Bsz, c, L, G, J, P)
    a_cum = jnp.cumsum(a, axis=-1)
    Lmat = jnp.exp(segsum(a))
    y_diag = jnp.einsum('bclgn,bcsgn,bgjcls,bcsgjp->bclgjp', Cm, Bm, Lmat, X)
    decay_states = jnp.exp(a_cum[..., -1:] - a_cum)
    states = jnp.einsum('bclgn,bgjcl,bclgjp->bcgjpn', Bm, decay_states, X)
    states = jnp.concatenate([jnp.zeros_like(states[:, :1]), states], axis=1)
    chunk_tot = jnp.pad(a_cum[..., -1], ((0, 0), (0, 0), (0, 0), (1, 0)))
    decay_chunk = jnp.exp(segsum(chunk_tot))
    states = jnp.einsum('bgjzc,bcgjpn->bzgjpn', decay_chunk, states)[:, :-1]
    y_off = jnp.einsum('bclgn,bcgjpn,bgjcl->bclgjp', Cm, states, jnp.exp(a_cum))
    y = (y_diag + y_off).reshape(Bsz, T, G, J, P) + xs * d_skip.reshape(G, J)[..., None]
    y = y.reshape(Bsz, T, G, J * P) * jax.nn.silu(z.astype(jnp.float32)).reshape(Bsz, T, G, J * P)
    y = rmsnorm(y, norm_g.reshape(G, J * P))
    return y.reshape(Bsz, T, SSM_WIDTH).astype(out_dtype)


def setup_inputs(seed: int = 0) -> dict:
    key = jax.random.key(seed)
    ks = jax.random.split(key, 26)

    def nrm(k, shape, scale):
        return jax.random.normal(k, shape, jnp.float32) * scale

    def gain(k, shape):
        return 1.0 + 0.02 * jax.random.normal(k, shape, jnp.float32)

    dt0 = jnp.exp(jax.random.uniform(ks[13], (DEPTH, SSM_HEADS), jnp.float32,
                                     minval=math.log(1e-3), maxval=math.log(1e-1)))
    return {
        "x": nrm(ks[0], (BATCH, SEQ, D_MODEL), 1.0),
        "positions": jnp.broadcast_to(jnp.arange(SEQ, dtype=jnp.int32), (BATCH, SEQ)),
        "mix_norm": gain(ks[1], (DEPTH, D_MODEL)),
        "w_in": nrm(ks[2], (DEPTH, D_MODEL, IN_COLS), D_MODEL ** -0.5),
        "hg_lb_logits": nrm(ks[3], (DEPTH, HG_HEADS * HG_DK), 0.5),
        "hg_norm": gain(ks[4], (DEPTH, HG_WIDTH)),
        "mla_q_norm": gain(ks[5], (DEPTH, MLA_Q_LORA)),
        "mla_kv_norm": gain(ks[6], (DEPTH, MLA_KV_LORA)),
        "mla_w_uq": nrm(ks[7], (DEPTH, MLA_Q_LORA, MLA_HEADS * (MLA_NOPE + MLA_ROPE)), MLA_Q_LORA ** -0.5),
        "mla_w_ukv": nrm(ks[8], (DEPTH, MLA_KV_LORA, MLA_HEADS * (MLA_NOPE + MLA_V)), MLA_KV_LORA ** -0.5),
        "ssm_conv_w": nrm(ks[9], (DEPTH, SSM_CONV, SSM_CONV_DIM), SSM_CONV ** -0.5),
        "ssm_conv_b": nrm(ks[10], (DEPTH, SSM_CONV_DIM), 0.02),
        "ssm_dt_bias": dt0 + jnp.log(-jnp.expm1(-dt0)),
        "ssm_a_log": jnp.log(jax.random.uniform(ks[11], (DEPTH, SSM_HEADS), jnp.float32, minval=1.0, maxval=16.0)),
        "ssm_d": 1.0 + 0.1 * jax.random.normal(ks[12], (DEPTH, SSM_HEADS), jnp.float32),
        "ssm_norm": gain(ks[14], (DEPTH, SSM_WIDTH)),
        "w_br_hg": nrm(ks[15], (DEPTH, HG_WIDTH, D_MODEL), HG_WIDTH ** -0.5),
        "w_br_mla": nrm(ks[16], (DEPTH, MLA_WIDTH, D_MODEL), MLA_WIDTH ** -0.5),
        "w_br_ssm": nrm(ks[17], (DEPTH, SSM_WIDTH, D_MODEL), SSM_WIDTH ** -0.5),
        "w_out": nrm(ks[18], (DEPTH, D_MODEL, D_MODEL), D_MODEL ** -0.5),
        "mlp_norm": gain(ks[19], (DEPTH, D_MODEL)),
        "w_up": nrm(ks[20], (DEPTH, D_MODEL, D_FF), D_MODEL ** -0.5),
        "w_down": nrm(ks[21], (DEPTH, D_FF, D_MODEL), 0.5 * D_FF ** -0.5),
        "final_norm": gain(ks[22], (D_MODEL,)),
    }


def reference(x, positions, mix_norm, w_in, hg_lb_logits, hg_norm, mla_q_norm, mla_kv_norm,
              mla_w_uq, mla_w_ukv, ssm_conv_w, ssm_conv_b, ssm_dt_bias, ssm_a_log, ssm_d, ssm_norm,
              w_br_hg, w_br_mla, w_br_ssm, w_out, mlp_norm, w_up, w_down, final_norm):
    Bsz, T, _ = x.shape
    split_pts = [int(s) for s in np.cumsum(COL_SIZES)[:-1]]
    lbs = jnp.cumsum(jax.nn.softmax(hg_lb_logits.astype(jnp.float32), axis=0), axis=0)
    lbs = lbs - lbs[0:1]
    for l in range(DEPTH):
        h = rmsnorm(x, mix_norm[l])
        proj = h @ w_in[l]
        (hq, hf, hi, hg, cq, ckv, kr, sz, sxbc, sdt, gate_raw) = jnp.split(proj, split_pts, axis=-1)
        y_a = hgrn2_mixer(hq, hf, hi, hg, lbs[l], hg_norm[l])
        y_b = mla_mixer(cq, ckv, kr, positions, mla_q_norm[l], mla_kv_norm[l], mla_w_uq[l], mla_w_ukv[l])
        y_c = mamba2_mixer(sz, sxbc, sdt, ssm_conv_w[l], ssm_conv_b[l], ssm_dt_bias[l], ssm_a_log[l],
                           ssm_d[l], ssm_norm[l])
        gates = jax.nn.sigmoid(gate_raw).reshape(Bsz, T, N_BRANCH, D_MODEL)
        merged = (gates[:, :, 0] * (y_a @ w_br_hg[l])
                  + gates[:, :, 1] * (y_b @ w_br_mla[l])
                  + gates[:, :, 2] * (y_c @ w_br_ssm[l]))
        x = x + (merged @ w_out[l]).astype(x.dtype)
        h = rmsnorm(x, mlp_norm[l])
        x = x + (jnp.square(jax.nn.relu(h @ w_up[l])) @ w_down[l]).astype(x.dtype)
    return rmsnorm(x, final_norm)
```

```cpp
#include <hip/hip_runtime.h>
#include <hip/hip_cooperative_groups.h>
#include <cstdio>
#include <cstdint>
namespace cg = cooperative_groups;

typedef unsigned short bf16_t;
typedef short bf16x8 __attribute__((ext_vector_type(8)));
typedef short s16x4 __attribute__((ext_vector_type(4)));
typedef float f32x4 __attribute__((ext_vector_type(4)));
typedef float f32x16 __attribute__((ext_vector_type(16)));
typedef unsigned u32x4 __attribute__((ext_vector_type(4)));
typedef unsigned u32x2 __attribute__((ext_vector_type(2)));
#define LAS __attribute__((address_space(3)))

constexpr int DM = 1024, NB = 8, SEQ = 4096, DEPTH = 4, MTOK = NB * SEQ;
constexpr int LDP = 4096;
constexpr int C_HQ = 0, C_HF = 512, C_HI = 1024, C_HG = 1536, C_CQ = 2048, C_CKV = 2432, C_KR = 2688, C_SZ = 2720, C_XBC = 3232, C_DT = 4000;
constexpr int C_YA = C_HQ, C_YB = C_CQ, C_YC = C_SZ;
constexpr int IN_COLS = 7080, NPROJ = 4008, DFF = 4096;
constexpr float EPS = 1e-6f;
constexpr float QSCALE = 0.10206207261596575f * 1.4426950408889634f;

constexpr size_t MiB = 1u << 20;
constexpr size_t WS_WIN = 1 * MiB;
constexpr size_t WS_WUQ = 15 * MiB;
constexpr size_t WS_WUK = 16 * MiB;
constexpr size_t WS_WUV = WS_WUK + 512 * 256 * 2;
constexpr size_t WS_WBR = 17 * MiB;
constexpr size_t WS_WOUT = 20 * MiB;
constexpr size_t WS_WUP = 22 * MiB;
constexpr size_t WS_WDN = 30 * MiB;
constexpr size_t WS_ROPE = 38 * MiB;
constexpr size_t WS_LBS = 42 * MiB;
constexpr size_t WS_HGD = 42 * MiB + 65536;
constexpr size_t WS_MAT = 43 * MiB + 131072;
constexpr size_t WS_SSQA = 492 * MiB;
constexpr size_t WS_SSQB = 494 * MiB;
constexpr size_t WS_H = 44 * MiB;
constexpr size_t WS_P = 108 * MiB;
constexpr size_t WS_R = 364 * MiB;
constexpr size_t WS_HST = WS_R;
constexpr size_t WS_MST = WS_R + 64 * MiB;
constexpr size_t WS_Q = WS_R;
constexpr size_t WS_KN = WS_R + 48 * MiB;
constexpr size_t WS_VT = WS_R + 80 * MiB;
constexpr size_t WS_KRP = WS_R + 112 * MiB;
constexpr size_t WS_G = WS_R;
constexpr size_t WS_MG = WS_R + 64 * MiB;
constexpr size_t WS_END = 496 * MiB;

__device__ __forceinline__ float bf2f(unsigned v) { return __uint_as_float(v << 16); }
__device__ __forceinline__ unsigned f2bf(float f) { unsigned u = __float_as_uint(f); return (u + 0x7fffu + ((u >> 16) & 1u)) >> 16; }
__device__ __forceinline__ unsigned pk2(float lo, float hi) { return f2bf(lo) | (f2bf(hi) << 16); }
typedef float f32x2_t __attribute__((ext_vector_type(2))); typedef __bf16 bf16x2_t __attribute__((ext_vector_type(2)));
__device__ __forceinline__ unsigned cvt_pk_bf16(float lo, float hi) { f32x2_t v = {lo, hi}; bf16x2_t b = __builtin_convertvector(v, bf16x2_t); return __builtin_bit_cast(unsigned, b); }
__device__ __forceinline__ float sigmoidf_(float x) { return __builtin_amdgcn_rcpf(1.f + __expf(-x)); }
__device__ __forceinline__ float siluf_(float x) { return x * sigmoidf_(x); }
__device__ __forceinline__ int crow(int r, int h) { return (r & 3) + 8 * (r >> 2) + 4 * h; }
__device__ __forceinline__ float wave_sum(float v) {
#pragma unroll
    for (int o = 1; o < 64; o <<= 1) v += __shfl_xor(v, o);
    return v;
}
__device__ __forceinline__ int mk_tid(int wid0) { int l; asm volatile("v_mbcnt_lo_u32_b32 %0, -1, 0\n\tv_mbcnt_hi_u32_b32 %0, -1, %0" : "=v"(l)); return l + wid0 * 64; }
#define MFMA32(a, b, c) __builtin_amdgcn_mfma_f32_32x32x16_bf16((a), (b), (c), 0, 0, 0)
__device__ __forceinline__ bf16x8 pack8(const f32x16& c, int s) {
    u32x4 w; w.x = cvt_pk_bf16(c[8 * s + 0], c[8 * s + 1]); w.y = cvt_pk_bf16(c[8 * s + 2], c[8 * s + 3]);
    w.z = cvt_pk_bf16(c[8 * s + 4], c[8 * s + 5]); w.w = cvt_pk_bf16(c[8 * s + 6], c[8 * s + 7]); return __builtin_bit_cast(bf16x8, w);
}
__device__ __forceinline__ bf16x8 ld2x64(const unsigned char* p0, const unsigned char* p1) {
    const u32x2 a = *(const u32x2*)p0, b = *(const u32x2*)p1; u32x4 w; w.x = a.x; w.y = a.y; w.z = b.x; w.w = b.y; return __builtin_bit_cast(bf16x8, w);
}

namespace pg8 {
constexpr int BM = 256, BK = 64, HALF = 128, HTB = HALF * BK * 2, STAGE_BYTES = 8 * HTB, NXCD = 8, WGM = 8;
__host__ __device__ __forceinline__ int lds_byte(int r, int c) { const int st = (r >> 4) * 2 + (c >> 5), rr = r & 15, cc = c & 31, ob = rr * 64 + cc * 2; return st * 1024 + (ob ^ (((ob >> 9) & 1) << 5)); }
__host__ __device__ __forceinline__ void stage_rc(int b, int& R, int& C) { const int st = b / 1024, sb = b % 1024, swz = sb ^ (((sb >> 9) & 1) << 5); R = (st >> 1) * 16 + swz / 64; C = (st & 1) * 32 + (swz % 64) / 2; }
__host__ __device__ __forceinline__ int perm32(int rho) { const int n = rho >> 4, i = rho & 15; return 8 * (i >> 2) + 4 * n + (i & 3); }
struct Unit { int pm, pn; };
struct Gemm { const bf16_t* A; const bf16_t* Bt; int M, N, K, lda; };
struct StaticOrder {
    int nM, nN, nwg, G, c;
    __device__ void init(int M, int N, int G_, int c_) { nM = M / BM; nN = N / BM; nwg = nM * nN; G = G_; c = c_; }
    __device__ bool next(int i, Unit& u) const {
        const long L = (long)i * G + c; if (L >= nwg) return false;
        int wgid = (int)L; { const int q = nwg / NXCD, r = nwg % NXCD, xcd = wgid % NXCD, off = wgid / NXCD; wgid = (xcd < r ? xcd * (q + 1) : r * (q + 1) + (xcd - r) * q) + off; }
        const int nig = WGM * nN, gid = wgid / nig, fm = gid * WGM, gsz = (nM - fm) < WGM ? (nM - fm) : WGM;
        u.pm = fm + ((wgid % nig) % gsz); u.pn = (wgid % nig) / gsz; return true;
    }
};
template <class Epi>
__device__ __forceinline__ void gemm_phase(int wid0, LAS unsigned char* lds, const Gemm g, const StaticOrder& S, const Epi& E) {
    const int tid = mk_tid(wid0);
    const int wid = __builtin_amdgcn_readfirstlane(tid >> 6), lane = tid & 63, wr = wid >> 2, wc = wid & 3, fr = lane & 15, fq = lane >> 4;
    int K = g.K; asm volatile("" : "+s"(K));
    const int nt = K / BK, lda = g.lda;
    unsigned voffA_, voffB_;
    { int R, C; stage_rc(tid * 16, R, C); const int Rb = Epi::PERM ? ((R & ~31) + perm32(R & 31)) : R;
      voffA_ = (unsigned)(R * lda + C) * 2u; voffB_ = (unsigned)(Rb * K + C) * 2u; }
    const unsigned voA = voffA_, voB = voffB_;
    const unsigned v2A = 64u * (unsigned)lda * 2u, v2B = 64u * (unsigned)K * 2u;
    const size_t kstep = (size_t)(BK * 2);
    const size_t hstepA = (size_t)HALF * lda * 2, tstepA = 2 * hstepA;
    const size_t hstepB = (size_t)HALF * K * 2, tstepB = 2 * hstepB;
    const unsigned ldsw = (unsigned)wid * 1024u;
    const int aoff = lds_byte(wr * 64 + fr, fq * 8), boff = lds_byte(wc * 32 + fr, fq * 8);
#define PG8_SA(b, h) (((b) * 2 + (h)) * HTB)
#define PG8_SB(b, h) ((4 + (b) * 2 + (h)) * HTB)
#define PG8_STAGE(bufoff, gbase, voff) do { _Pragma("unroll") for (int _i = 0; _i < 2; ++_i) \
        __builtin_amdgcn_global_load_lds((const unsigned*)((const char*)(gbase) + (size_t)(_i * v2##voff) + vo##voff), (LAS unsigned*)(lds + (bufoff) + ldsw + _i * 8192), 16, 0, 0); } while (0)
#define PG8_LDA(dst, b, h) do { _Pragma("unroll") for (int m = 0; m < 4; ++m) _Pragma("unroll") for (int k = 0; k < 2; ++k) dst[m][k] = *(const LAS bf16x8*)(lds + PG8_SA(b, h) + aoff + m * 2048 + k * 1024); } while (0)
#define PG8_LDB(dst, b, h) do { _Pragma("unroll") for (int n = 0; n < 2; ++n) _Pragma("unroll") for (int k = 0; k < 2; ++k) dst[n][k] = *(const LAS bf16x8*)(lds + PG8_SB(b, h) + boff + n * 2048 + k * 1024); } while (0)
#define PG8_MMA(ai, bj, At, Bt) do { __builtin_amdgcn_s_setprio(1); _Pragma("unroll") for (int m = 0; m < 4; ++m) _Pragma("unroll") for (int n = 0; n < 2; ++n) _Pragma("unroll") for (int k = 0; k < 2; ++k) \
        acc[ai][bj][m][n] = Epi::SWAP ? __builtin_amdgcn_mfma_f32_16x16x32_bf16(Bt[n][k], At[m][k], acc[ai][bj][m][n], 0, 0, 0) \
                                      : __builtin_amdgcn_mfma_f32_16x16x32_bf16(At[m][k], Bt[n][k], acc[ai][bj][m][n], 0, 0, 0); __builtin_amdgcn_s_setprio(0); } while (0)
#define PG8_WAIT_V(n) asm volatile("s_waitcnt vmcnt(" #n ")" ::: "memory")
#define PG8_WAIT_L(n) asm volatile("s_waitcnt lgkmcnt(" #n ")" ::: "memory")
#define PG8_BAR __builtin_amdgcn_s_barrier()
#define PG8_SCHED __builtin_amdgcn_sched_barrier(0)
    Unit cur, nxt; int ui = 0;
    if (!S.next(0, cur)) return;
    f32x4 acc[2][2][4][2];
#pragma unroll
    for (int a = 0; a < 2; ++a)
#pragma unroll
        for (int b = 0; b < 2; ++b)
#pragma unroll
            for (int m = 0; m < 4; ++m)
#pragma unroll
                for (int n = 0; n < 2; ++n) acc[a][b][m][n] = (f32x4){0.f, 0.f, 0.f, 0.f};
    bf16x8 At[4][2], B0[2][2], B1[2][2];
    const char* cA = (const char*)g.A + (size_t)cur.pm * tstepA; const char* cB = (const char*)g.Bt + (size_t)cur.pn * tstepB;
    LAS float* const tab0 = (LAS float*)(lds + STAGE_BYTES);
    if constexpr (Epi::HAS_PRE) E.pre(tab0, cur, tid);
    PG8_STAGE(PG8_SB(0, 0), cB, B); PG8_STAGE(PG8_SB(0, 1), cB + hstepB, B); PG8_STAGE(PG8_SA(0, 0), cA, A); PG8_STAGE(PG8_SA(0, 1), cA + hstepA, A);
    if (wr == 1) PG8_BAR;
    PG8_WAIT_V(2); PG8_BAR;
    PG8_STAGE(PG8_SB(1, 0), cB + kstep, B); PG8_STAGE(PG8_SA(1, 0), cA + kstep, A); PG8_STAGE(PG8_SB(1, 1), cB + hstepB + kstep, B);
    PG8_WAIT_V(6); PG8_BAR;
    for (;;) {
        const bool has_next = S.next(ui + 1, nxt);
        const char* nA = has_next ? (const char*)g.A + (size_t)nxt.pm * tstepA : cA; const char* nB = has_next ? (const char*)g.Bt + (size_t)nxt.pn * tstepB : cB;
        for (int t = 0; t < nt; t += 2) {
            const bool last = (t == nt - 2);
            const char* a1 = cA + (size_t)(t + 1) * kstep;
            const char* a2 = last ? nA : cA + (size_t)(t + 2) * kstep; const char* b2 = last ? nB : cB + (size_t)(t + 2) * kstep;
            const char* a3 = a2 + kstep; const char* b3 = b2 + kstep;
            PG8_LDB(B0, 0, 0); PG8_LDB(B1, 0, 1); PG8_SCHED; PG8_LDA(At, 0, 0); PG8_STAGE(PG8_SA(1, 1), a1 + hstepA, A);
            PG8_WAIT_V(8); PG8_WAIT_L(0); PG8_BAR; PG8_MMA(0, 0, At, B0); PG8_MMA(0, 1, At, B1); PG8_BAR; PG8_SCHED;
            PG8_LDA(At, 0, 1); PG8_STAGE(PG8_SB(0, 0), b2, B); PG8_STAGE(PG8_SB(0, 1), b2 + hstepB, B); PG8_STAGE(PG8_SA(0, 0), a2, A);
            PG8_WAIT_V(8); PG8_WAIT_L(0); PG8_BAR; PG8_MMA(1, 0, At, B0); PG8_MMA(1, 1, At, B1); PG8_BAR; PG8_SCHED;
            PG8_LDB(B0, 1, 0); PG8_LDB(B1, 1, 1); PG8_SCHED; PG8_LDA(At, 1, 0); PG8_STAGE(PG8_SA(0, 1), a2 + hstepA, A);
            PG8_WAIT_V(8); PG8_WAIT_L(0); PG8_BAR; PG8_MMA(0, 0, At, B0); PG8_MMA(0, 1, At, B1); PG8_BAR; PG8_SCHED;
            PG8_LDA(At, 1, 1); PG8_STAGE(PG8_SB(1, 0), b3, B); PG8_STAGE(PG8_SB(1, 1), b3 + hstepB, B); PG8_STAGE(PG8_SA(1, 0), a3, A);
            PG8_WAIT_V(8); PG8_WAIT_L(0); PG8_BAR; PG8_MMA(1, 0, At, B0); PG8_MMA(1, 1, At, B1); PG8_BAR; PG8_SCHED;
        }
        if (wr == 0) PG8_BAR;
        { int le; asm volatile("v_mbcnt_lo_u32_b32 %0, -1, 0\n\tv_mbcnt_hi_u32_b32 %0, -1, %0" : "=v"(le));
          E(acc, cur, wr, wc, le & 15, le >> 4, tab0 + (ui & 1) * 256); }
        if (!has_next) break;
#pragma unroll
        for (int a = 0; a < 2; ++a)
#pragma unroll
            for (int b = 0; b < 2; ++b)
#pragma unroll
                for (int m = 0; m < 4; ++m)
#pragma unroll
                    for (int n = 0; n < 2; ++n) acc[a][b][m][n] = (f32x4){0.f, 0.f, 0.f, 0.f};
        cur = nxt; cA = nA; cB = nB; ++ui;
        if constexpr (Epi::HAS_PRE) E.pre(tab0 + (ui & 1) * 256, cur, mk_tid(wid0));
        if (wr == 1) PG8_BAR;
    }
    PG8_WAIT_V(0);
    PG8_BAR;
#undef PG8_SA
#undef PG8_SB
#undef PG8_STAGE
#undef PG8_LDA
#undef PG8_LDB
#undef PG8_MMA
#undef PG8_WAIT_V
#undef PG8_WAIT_L
#undef PG8_BAR
#undef PG8_SCHED
}

template <int ACT, int MODE> struct EpiBf16 {
    static constexpr bool PERM = true, SWAP = true, HAS_PRE = true;
    bf16_t* O; int ldc; const bf16_t* Gt; int ldg; const float* ssq;
    __device__ __forceinline__ void pre(LAS float* tab, const Unit& u, int tid) const {
        if (ssq && tid < 256) { const f32x4* sp = (const f32x4*)(ssq + (size_t)(u.pm * BM + tid) * 16); const f32x4 s0 = sp[0], s1 = sp[1], s2 = sp[2], s3 = sp[3];
            tab[tid] = rsqrtf(((((s0[0] + s0[1]) + (s0[2] + s0[3])) + ((s1[0] + s1[1]) + (s1[2] + s1[3]))) + (((s2[0] + s2[1]) + (s2[2] + s2[3])) + ((s3[0] + s3[1]) + (s3[2] + s3[3])))) * (1.f / DM) + EPS); }
    }
    __device__ __forceinline__ void operator()(const f32x4 (&acc)[2][2][4][2], const Unit& u, int wr, int wc, int fr, int fq, const LAS float* tab) const {
        const int row0 = u.pm * BM + wr * 64 + fr, col0 = u.pn * BM + wc * 32 + 8 * fq;
#pragma unroll
        for (int ai = 0; ai < 2; ++ai)
#pragma unroll
            for (int m = 0; m < 4; ++m) { const size_t r = (size_t)(row0 + ai * HALF + m * 16); bf16_t* rowp = O + r * ldc + col0; const float rs = ssq ? tab[ai * HALF + wr * 64 + m * 16 + fr] : 1.f;
#pragma unroll
                for (int bj = 0; bj < 2; ++bj) { f32x4 v0 = acc[ai][bj][m][0], v1 = acc[ai][bj][m][1];
                    float v[8] = {v0[0] * rs, v0[1] * rs, v0[2] * rs, v0[3] * rs, v1[0] * rs, v1[1] * rs, v1[2] * rs, v1[3] * rs};
                    if (ACT == 1) {
#pragma unroll
                        for (int e = 0; e < 8; ++e) { const float t = v[e] > 0.f ? v[e] : 0.f; v[e] = t * t; } }
                    if (ACT == 2) {
#pragma unroll
                        for (int e = 0; e < 8; ++e) v[e] = sigmoidf_(v[e]); }
                    if (MODE >= 1) { const u32x4 gw = *(const u32x4*)(Gt + r * ldg + col0 + bj * HALF);
                        const unsigned gg[4] = {gw.x, gw.y, gw.z, gw.w};
#pragma unroll
                        for (int e = 0; e < 4; ++e) { v[2 * e] *= bf2f(gg[e] & 0xffffu); v[2 * e + 1] *= bf2f(gg[e] >> 16); } }
                    if (MODE == 2) { const u32x4 ow = *(const u32x4*)(rowp + bj * HALF);
                        const unsigned oo[4] = {ow.x, ow.y, ow.z, ow.w};
#pragma unroll
                        for (int e = 0; e < 4; ++e) { v[2 * e] += bf2f(oo[e] & 0xffffu); v[2 * e + 1] += bf2f(oo[e] >> 16); } }
                    u32x4 w; w.x = cvt_pk_bf16(v[0], v[1]); w.y = cvt_pk_bf16(v[2], v[3]); w.z = cvt_pk_bf16(v[4], v[5]); w.w = cvt_pk_bf16(v[6], v[7]);
                    *(u32x4*)(rowp + bj * HALF) = w; } }
    }
};
struct EpiRes {
    static constexpr bool PERM = false, SWAP = true, HAS_PRE = false;
    bf16_t* xb; float* ssq;
    __device__ __forceinline__ void operator()(const f32x4 (&acc)[2][2][4][2], const Unit& u, int wr, int wc, int fr, int fq, const LAS float* tab) const {
        const int col0 = u.pn * BM + wc * 32 + 4 * fq; const int r0 = u.pm * BM + wr * 64 + fr;
        bf16_t* xp = xb + (size_t)r0 * DM + col0;
#pragma unroll
        for (int ai = 0; ai < 2; ++ai) {
            u32x2 bs[4][2][2];
#pragma unroll
            for (int m = 0; m < 4; ++m)
#pragma unroll
                for (int bj = 0; bj < 2; ++bj)
#pragma unroll
                    for (int n = 0; n < 2; ++n) bs[m][bj][n] = *(const u32x2*)(xp + (size_t)(ai * HALF + m * 16) * DM + bj * HALF + n * 16);
            asm volatile("" ::: "memory");
#pragma unroll
            for (int m = 0; m < 4; ++m) { float sq = 0.f;
#pragma unroll
                for (int bj = 0; bj < 2; ++bj)
#pragma unroll
                    for (int n = 0; n < 2; ++n) { const u32x2 bw = bs[m][bj][n]; const f32x4 a = acc[ai][bj][m][n];
                        const float v0 = bf2f(bw.x & 0xffffu) + a[0], v1 = bf2f(bw.x >> 16) + a[1], v2 = bf2f(bw.y & 0xffffu) + a[2], v3 = bf2f(bw.y >> 16) + a[3];
                        sq += (v0 * v0 + v1 * v1) + (v2 * v2 + v3 * v3);
                        u32x2 w; w.x = cvt_pk_bf16(v0, v1); w.y = cvt_pk_bf16(v2, v3); *(u32x2*)(xp + (size_t)(ai * HALF + m * 16) * DM + bj * HALF + n * 16) = w; }
                sq += __shfl_xor(sq, 16); sq += __shfl_xor(sq, 32);
                if (fq == 0) ssq[(size_t)(r0 + ai * HALF + m * 16) * 16 + u.pn * 4 + wc] = sq; }
            asm volatile("" ::: "memory"); }
    }
};
struct EpiQ {
    static constexpr bool PERM = false, SWAP = true, HAS_PRE = false;
    bf16_t* O; const float* rope;
    __device__ __forceinline__ void operator()(const f32x4 (&acc)[2][2][4][2], const Unit& u, int wr, int wc, int fr, int fq, const LAS float* tab) const {
        const int r0 = u.pm * BM + wr * 64 + fr, g0 = u.pn * 8 + wc;
        bf16_t* ob = O + (size_t)r0 * 768 + g0 * 32 + 4 * fq; const float* rb = rope + (size_t)r0 * 32 + 4 * fq;
#pragma unroll
        for (int bj = 0; bj < 2; ++bj) { const bool isrope = ((g0 + 4 * bj) % 3) == 2;
#pragma unroll
            for (int ai = 0; ai < 2; ++ai)
#pragma unroll
                for (int m = 0; m < 4; ++m) { const int ro = ai * HALF + m * 16;
                    f32x4 x1 = acc[ai][bj][m][0], x2 = acc[ai][bj][m][1];
                    if (isrope) { const f32x4 c = *(const f32x4*)(rb + ro * 32), s = *(const f32x4*)(rb + ro * 32 + 16);
                        const f32x4 y1 = x1 * c - x2 * s, y2 = x2 * c + x1 * s; x1 = y1; x2 = y2; }
                    x1 = x1 * QSCALE; x2 = x2 * QSCALE;
                    u32x2 w1, w2; w1.x = cvt_pk_bf16(x1[0], x1[1]); w1.y = cvt_pk_bf16(x1[2], x1[3]); w2.x = cvt_pk_bf16(x2[0], x2[1]); w2.y = cvt_pk_bf16(x2[2], x2[3]);
                    *(u32x2*)(ob + ro * 768 + bj * 128) = w1; *(u32x2*)(ob + ro * 768 + bj * 128 + 16) = w2; asm volatile("" ::: "memory"); } }
    }
};
struct EpiVT {
    static constexpr bool PERM = false, SWAP = false, HAS_PRE = false;
    bf16_t* VT;
    __device__ __forceinline__ void operator()(const f32x4 (&acc)[2][2][4][2], const Unit& u, int wr, int wc, int fr, int fq, const LAS float* tab) const {
        const int c0 = u.pn * BM + wc * 32 + fr, r0 = u.pm * BM + wr * 64 + 4 * fq;
        bf16_t* base = VT + ((size_t)(((r0 >> 12) * 8 + (c0 >> 6)) * 64 + (c0 & 63))) * SEQ + (r0 & 4095);
#pragma unroll
        for (int bj = 0; bj < 2; ++bj)
#pragma unroll
            for (int n = 0; n < 2; ++n)
#pragma unroll
                for (int ai = 0; ai < 2; ++ai)
#pragma unroll
                    for (int m = 0; m < 4; ++m) { const f32x4 v = acc[ai][bj][m][n]; u32x2 w; w.x = cvt_pk_bf16(v[0], v[1]); w.y = cvt_pk_bf16(v[2], v[3]);
                        *(u32x2*)(base + (size_t)(bj * 128 + n * 16) * SEQ + ai * HALF + m * 16) = w; }
    }
};
struct MergeArgs { const bf16_t* H; const bf16_t* P; const bf16_t* Wg; const bf16_t* Wbr; };
template <class EpiG, class EpiB1, class EpiB2>
__device__ __forceinline__ void gemm_merge(int wid0, LAS unsigned char* lds, const MergeArgs ma, const StaticOrder& S, const EpiG& EG, const EpiB1& EB1, const EpiB2& EB2) {
    const int tid = mk_tid(wid0);
    const int wid = __builtin_amdgcn_readfirstlane(tid >> 6), lane = tid & 63, wr = wid >> 2, wc = wid & 3, fr = lane & 15, fq = lane >> 4;
    int KG = DM, KH = 512; asm volatile("" : "+s"(KG)); asm volatile("" : "+s"(KH));
    unsigned voA0, voA1, voB0, voB1;
    { int R, C; stage_rc(tid * 16, R, C); const int Rb = (R & ~31) + perm32(R & 31);
      voA0 = (unsigned)(R * DM + C) * 2u; voA1 = (unsigned)(R * LDP + C) * 2u; voB0 = (unsigned)(Rb * KG + C) * 2u; voB1 = (unsigned)(Rb * KH + C) * 2u; }
    const size_t kstep = (size_t)(BK * 2);
    const unsigned ldsw = (unsigned)wid * 1024u;
    const int aoff = lds_byte(wr * 64 + fr, fq * 8), boff = lds_byte(wc * 32 + fr, fq * 8);
#define PG8_SA(b, h) (((b) * 2 + (h)) * HTB)
#define PG8_SB(b, h) ((4 + (b) * 2 + (h)) * HTB)
#define PG8_STG(bufoff, gbase, vo, v2) do { _Pragma("unroll") for (int _i = 0; _i < 2; ++_i) \
        __builtin_amdgcn_global_load_lds((const unsigned*)((const char*)(gbase) + (size_t)(_i * (v2)) + (vo)), (LAS unsigned*)(lds + (bufoff) + ldsw + _i * 8192), 16, 0, 0); } while (0)
#define PG8_LDA(dst, b, h) do { _Pragma("unroll") for (int m = 0; m < 4; ++m) _Pragma("unroll") for (int k = 0; k < 2; ++k) dst[m][k] = *(const LAS bf16x8*)(lds + PG8_SA(b, h) + aoff + m * 2048 + k * 1024); } while (0)
#define PG8_LDB(dst, b, h) do { _Pragma("unroll") for (int n = 0; n < 2; ++n) _Pragma("unroll") for (int k = 0; k < 2; ++k) dst[n][k] = *(const LAS bf16x8*)(lds + PG8_SB(b, h) + boff + n * 2048 + k * 1024); } while (0)
#define PG8_MMA(ai, bj, At, Bt) do { __builtin_amdgcn_s_setprio(1); _Pragma("unroll") for (int m = 0; m < 4; ++m) _Pragma("unroll") for (int n = 0; n < 2; ++n) _Pragma("unroll") for (int k = 0; k < 2; ++k) \
        acc[ai][bj][m][n] = __builtin_amdgcn_mfma_f32_16x16x32_bf16(Bt[n][k], At[m][k], acc[ai][bj][m][n], 0, 0, 0); __builtin_amdgcn_s_setprio(0); } while (0)
#define PG8_WAIT_V(n) asm volatile("s_waitcnt vmcnt(" #n ")" ::: "memory")
#define PG8_WAIT_L(n) asm volatile("s_waitcnt lgkmcnt(" #n ")" ::: "memory")
#define PG8_BAR __builtin_amdgcn_s_barrier()
#define PG8_SCHED __builtin_amdgcn_sched_barrier(0)
#define MG_ITEM(it, U, KIND, PA, PB) do { const int j_ = (it) % 6, i_ = j_ >> 1; KIND = j_ & 1; \
        PA = KIND ? (const char*)(ma.P + (i_ == 0 ? C_YA : (i_ == 1 ? C_YB : C_YC)) + (size_t)U.pm * BM * LDP) : (const char*)(ma.H + (size_t)U.pm * BM * DM); \
        PB = KIND ? (const char*)(ma.Wbr + ((size_t)i_ * DM + (size_t)U.pn * BM) * 512) : (const char*)(ma.Wg + ((size_t)i_ * DM + (size_t)U.pn * BM) * DM); } while (0)
    Unit cur, nxt; int it = 0;
    if (!S.next(0, cur)) return;
    f32x4 acc[2][2][4][2];
#pragma unroll
    for (int a = 0; a < 2; ++a)
#pragma unroll
        for (int b = 0; b < 2; ++b)
#pragma unroll
            for (int m = 0; m < 4; ++m)
#pragma unroll
                for (int n = 0; n < 2; ++n) acc[a][b][m][n] = (f32x4){0.f, 0.f, 0.f, 0.f};
    bf16x8 At[4][2], B0[2][2], B1[2][2];
    int ck; const char* cA; const char* cB; MG_ITEM(0, cur, ck, cA, cB);
    LAS float* const tab0 = (LAS float*)(lds + STAGE_BYTES);
    EG.pre(tab0, cur, tid);
    { const unsigned voA = ck ? voA1 : voA0, voB = ck ? voB1 : voB0, v2A = 128u * (ck ? LDP : DM), v2B = 128u * (unsigned)(ck ? KH : KG); const size_t hA = 2 * (size_t)v2A, hB = 2 * (size_t)v2B;
      PG8_STG(PG8_SB(0, 0), cB, voB, v2B); PG8_STG(PG8_SB(0, 1), cB + hB, voB, v2B); PG8_STG(PG8_SA(0, 0), cA, voA, v2A); PG8_STG(PG8_SA(0, 1), cA + hA, voA, v2A);
      if (wr == 1) PG8_BAR;
      PG8_WAIT_V(2); PG8_BAR;
      PG8_STG(PG8_SB(1, 0), cB + kstep, voB, v2B); PG8_STG(PG8_SA(1, 0), cA + kstep, voA, v2A); PG8_STG(PG8_SB(1, 1), cB + hB + kstep, voB, v2B);
      PG8_WAIT_V(6); PG8_BAR; }
    for (;;) {
        const int j = it % 6;
        bool has_next; int nk; const char* nA; const char* nB;
        if (j < 5) { has_next = true; nxt = cur; } else { has_next = S.next(it / 6 + 1, nxt); }
        if (has_next) MG_ITEM(it + 1, nxt, nk, nA, nB); else { nk = ck; nA = cA; nB = cB; }
        const unsigned cvoA = ck ? voA1 : voA0, cvoB = ck ? voB1 : voB0, cv2A = 128u * (ck ? LDP : DM), cv2B = 128u * (unsigned)(ck ? KH : KG); const size_t chA = 2 * (size_t)cv2A, chB = 2 * (size_t)cv2B;
        const unsigned nvoA = nk ? voA1 : voA0, nvoB = nk ? voB1 : voB0, nv2A = 128u * (nk ? LDP : DM), nv2B = 128u * (unsigned)(nk ? KH : KG); const size_t nhA = 2 * (size_t)nv2A, nhB = 2 * (size_t)nv2B;
        const int nt = (ck ? KH : KG) / BK;
        for (int t = 0; t < nt; t += 2) {
            const bool last = (t == nt - 2);
            const char* a1 = cA + (size_t)(t + 1) * kstep;
            const char* a2 = last ? nA : cA + (size_t)(t + 2) * kstep; const char* b2 = last ? nB : cB + (size_t)(t + 2) * kstep;
            const char* a3 = a2 + kstep; const char* b3 = b2 + kstep;
            const unsigned xvoA = last ? nvoA : cvoA, xvoB = last ? nvoB : cvoB, xv2A = last ? nv2A : cv2A, xv2B = last ? nv2B : cv2B; const size_t xhA = last ? nhA : chA, xhB = last ? nhB : chB;
            PG8_LDB(B0, 0, 0); PG8_LDB(B1, 0, 1); PG8_SCHED; PG8_LDA(At, 0, 0); PG8_STG(PG8_SA(1, 1), a1 + chA, cvoA, cv2A);
            PG8_WAIT_V(8); PG8_WAIT_L(0); PG8_BAR; PG8_MMA(0, 0, At, B0); PG8_MMA(0, 1, At, B1); PG8_BAR; PG8_SCHED;
            PG8_LDA(At, 0, 1); PG8_STG(PG8_SB(0, 0), b2, xvoB, xv2B); PG8_STG(PG8_SB(0, 1), b2 + xhB, xvoB, xv2B); PG8_STG(PG8_SA(0, 0), a2, xvoA, xv2A);
            PG8_WAIT_V(8); PG8_WAIT_L(0); PG8_BAR; PG8_MMA(1, 0, At, B0); PG8_MMA(1, 1, At, B1); PG8_BAR; PG8_SCHED;
            PG8_LDB(B0, 1, 0); PG8_LDB(B1, 1, 1); PG8_SCHED; PG8_LDA(At, 1, 0); PG8_STG(PG8_SA(0, 1), a2 + xhA, xvoA, xv2A);
            PG8_WAIT_V(8); PG8_WAIT_L(0); PG8_BAR; PG8_MMA(0, 0, At, B0); PG8_MMA(0, 1, At, B1); PG8_BAR; PG8_SCHED;
            PG8_LDA(At, 1, 1); PG8_STG(PG8_SB(1, 0), b3, xvoB, xv2B); PG8_STG(PG8_SB(1, 1), b3 + xhB, xvoB, xv2B); PG8_STG(PG8_SA(1, 0), a3, xvoA, xv2A);
            PG8_WAIT_V(8); PG8_WAIT_L(0); PG8_BAR; PG8_MMA(1, 0, At, B0); PG8_MMA(1, 1, At, B1); PG8_BAR; PG8_SCHED;
        }
        if (wr == 0) PG8_BAR;
        { int le; asm volatile("v_mbcnt_lo_u32_b32 %0, -1, 0\n\tv_mbcnt_hi_u32_b32 %0, -1, %0" : "=v"(le));
          const LAS float* tb = tab0 + ((it / 6) & 1) * 256;
          if ((j & 1) == 0) EG(acc, cur, wr, wc, le & 15, le >> 4, tb); else if (j == 1) EB1(acc, cur, wr, wc, le & 15, le >> 4, tb); else EB2(acc, cur, wr, wc, le & 15, le >> 4, tb); }
        if (!has_next) break;
#pragma unroll
        for (int a = 0; a < 2; ++a)
#pragma unroll
            for (int b = 0; b < 2; ++b)
#pragma unroll
                for (int m = 0; m < 4; ++m)
#pragma unroll
                    for (int n = 0; n < 2; ++n) acc[a][b][m][n] = (f32x4){0.f, 0.f, 0.f, 0.f};
        ++it; ck = nk; cA = nA; cB = nB;
        if (j == 5) { cur = nxt; EG.pre(tab0 + ((it / 6) & 1) * 256, cur, mk_tid(wid0)); }
        if (wr == 1) PG8_BAR;
    }
    PG8_WAIT_V(0);
    PG8_BAR;
#undef MG_ITEM
#undef PG8_SA
#undef PG8_SB
#undef PG8_STG
#undef PG8_LDA
#undef PG8_LDB
#undef PG8_MMA
#undef PG8_WAIT_V
#undef PG8_WAIT_L
#undef PG8_BAR
#undef PG8_SCHED
}

}

__device__ __forceinline__ void transpose_item(const float* W, int ldw, int K, bf16_t* WT, int mode, int shift, int nvalid, float* scr, int item, int nblk, int lane, const float* gain = nullptr) {
    const int kb = item / nblk, nb = item % nblk, k0 = 64 * kb, n0 = 32 * nb;
    const int n4 = n0 + 4 * (lane & 7), kr = lane >> 3;
    int src; bool valid = true;
    if (mode == 0) { src = n4 + shift; valid = n4 < nvalid; } else { src = (n4 >> 6) * 128 + (n4 & 63) + (mode == 2 ? 64 : 0); }
    f32x4 v[8];
#pragma unroll
    for (int i = 0; i < 8; ++i) v[i] = valid ? *(const f32x4*)(W + (size_t)(k0 + 8 * i + kr) * ldw + src) : (f32x4){0.f, 0.f, 0.f, 0.f};
#pragma unroll
    for (int i = 0; i < 8; ++i) { const int kk = 8 * i + kr; const float gq = gain ? gain[k0 + kk] : 1.f; float* d = scr + kk * 33 + 4 * (lane & 7);
        d[0] = v[i][0] * gq; d[1] = v[i][1] * gq; d[2] = v[i][2] * gq; d[3] = v[i][3] * gq; }
    asm volatile("s_waitcnt lgkmcnt(0)" ::: "memory");
    const int c = lane & 7;
#pragma unroll
    for (int j = 0; j < 4; ++j) { const int n = (lane >> 3) + 8 * j; const float* s = scr + (8 * c) * 33 + n;
        u32x4 o; o.x = pk2(s[0 * 33], s[1 * 33]); o.y = pk2(s[2 * 33], s[3 * 33]); o.z = pk2(s[4 * 33], s[5 * 33]); o.w = pk2(s[6 * 33], s[7 * 33]);
        *(u32x4*)(WT + (size_t)(n0 + n) * K + k0 + 8 * c) = o; }
    asm volatile("s_waitcnt lgkmcnt(0)" ::: "memory");
}
__device__ __forceinline__ void rms_row_bf16(const float* xrow, const float* gain, bf16_t* orow, int lane) {
    const f32x4* xr = (const f32x4*)xrow + lane; const f32x4* gr = (const f32x4*)gain + lane;
    f32x4 v[4]; float s = 0.f;
#pragma unroll
    for (int j = 0; j < 4; ++j) { v[j] = xr[64 * j]; s += (v[j].x * v[j].x + v[j].y * v[j].y) + (v[j].z * v[j].z + v[j].w * v[j].w); }
    const float rstd = rsqrtf(wave_sum(s) * (1.f / DM) + EPS);
    u32x2* o8 = (u32x2*)orow + lane;
#pragma unroll
    for (int j = 0; j < 4; ++j) { const f32x4 gg = gr[64 * j]; u32x2 w; w.x = pk2(v[j].x * rstd * gg.x, v[j].y * rstd * gg.y); w.y = pk2(v[j].z * rstd * gg.z, v[j].w * rstd * gg.w); o8[64 * j] = w; }
}
__device__ __forceinline__ void rms_row_f32(float* xrow, const float* gain, int lane) {
    f32x4* xr = (f32x4*)xrow + lane; const f32x4* gr = (const f32x4*)gain + lane;
    f32x4 v[4]; float s = 0.f;
#pragma unroll
    for (int j = 0; j < 4; ++j) { v[j] = xr[64 * j]; s += (v[j].x * v[j].x + v[j].y * v[j].y) + (v[j].z * v[j].z + v[j].w * v[j].w); }
    const float rstd = rsqrtf(wave_sum(s) * (1.f / DM) + EPS);
#pragma unroll
    for (int j = 0; j < 4; ++j) xr[64 * j] = v[j] * rstd * gr[64 * j];
}

struct Args { const float* in[24]; float* out; unsigned char* ws; int ph_lo, ph_hi; };
typedef const __attribute__((address_space(4))) Args* AP;

__device__ __forceinline__ void phase_weights(int wid0, int bid, const AP A, int l, unsigned char* wdst, unsigned char* lds, int G) {
    const int tid = mk_tid(wid0);
    const int lane = tid & 63, wave = tid >> 6;
    float* scr = (float*)(lds + wave * 16384);
    const int gw = bid * 8 + wave, NGW = G * 8;
    unsigned char* ws = A->ws;
    const float* w_in = A->in[3] + (size_t)l * DM * IN_COLS;
    const float* w_uq = A->in[8] + (size_t)l * 384 * 768;
    const float* w_ukv = A->in[9] + (size_t)l * 256 * 1024;
    const float* w_out = A->in[19] + (size_t)l * DM * DM;
    const float* w_up = A->in[21] + (size_t)l * DM * DFF;
    const float* w_dn = A->in[22] + (size_t)l * DFF * DM;
    constexpr int I0 = 16 * 128, I1 = 16 * 96, I2 = 6 * 24, I3 = 4 * 16, I4 = 4 * 16, I5 = 8 * 32, I8 = 16 * 32, I9 = 16 * 128, I10 = 64 * 32;
    constexpr int NIT = I0 + I1 + I2 + I3 + I4 + 3 * I5 + I8 + I9 + I10;
    for (int it = gw; it < NIT; it += NGW) {
        int r = it;
        if (r < I0) { transpose_item(w_in, IN_COLS, DM, (bf16_t*)(wdst + WS_WIN), 0, 0, NPROJ, scr, r, 128, lane, A->in[2] + l * DM); continue; } r -= I0;
        if (r < I1) { transpose_item(w_in, IN_COLS, DM, (bf16_t*)(wdst + WS_WIN) + (size_t)4096 * DM, 0, NPROJ, 1 << 30, scr, r, 96, lane, A->in[2] + l * DM); continue; } r -= I1;
        if (r < I2) { transpose_item(w_uq, 768, 384, (bf16_t*)(wdst + WS_WUQ), 0, 0, 1 << 30, scr, r, 24, lane); continue; } r -= I2;
        if (r < I3) { transpose_item(w_ukv, 1024, 256, (bf16_t*)(wdst + WS_WUK), 1, 0, 0, scr, r, 16, lane); continue; } r -= I3;
        if (r < I4) { transpose_item(w_ukv, 1024, 256, (bf16_t*)(wdst + WS_WUV), 2, 0, 0, scr, r, 16, lane); continue; } r -= I4;
        if (r < 3 * I5) { const int i = r / I5; const float* wb = A->in[16 + i] + (size_t)l * 512 * DM;
            transpose_item(wb, DM, 512, (bf16_t*)(wdst + WS_WBR) + (size_t)i * DM * 512, 0, 0, 1 << 30, scr, r % I5, 32, lane); continue; } r -= 3 * I5;
        if (r < I8) { transpose_item(w_out, DM, DM, (bf16_t*)(wdst + WS_WOUT), 0, 0, 1 << 30, scr, r, 32, lane); continue; } r -= I8;
        if (r < I9) { transpose_item(w_up, DFF, DM, (bf16_t*)(wdst + WS_WUP), 0, 0, 1 << 30, scr, r, 128, lane, A->in[20] + l * DM); continue; } r -= I9;
        transpose_item(w_dn, DM, DFF, (bf16_t*)(wdst + WS_WDN), 0, 0, 1 << 30, scr, r, 32, lane);
    }
    if (l == 0) {
        const int* pos = (const int*)A->in[1]; float* rope = (float*)(ws + WS_ROPE);
        for (int e = bid * 512 + tid; e < MTOK * 16; e += G * 512) {
            const int row = e >> 4, i = e & 15;
            const float inv = exp2f(-(float)(2 * i) * (1.f / 32.f) * 13.287712379549449f);
            const float ang = (float)pos[row] * inv;
            double t = (double)ang * 0.15915494309189535; t -= rint(t);
            rope[row * 32 + i] = __builtin_amdgcn_cosf((float)t); rope[row * 32 + 16 + i] = __builtin_amdgcn_sinf((float)t);
        }
        if (bid == 0) { const float* lg = A->in[4]; float* lbs = (float*)(ws + WS_LBS); const int j = tid;
            const float a0 = lg[j], a1 = lg[512 + j], a2 = lg[1024 + j], a3 = lg[1536 + j]; const float mx = fmaxf(fmaxf(a0, a1), fmaxf(a2, a3));
            const float e0 = __expf(a0 - mx), e1 = __expf(a1 - mx), e2 = __expf(a2 - mx), e3 = __expf(a3 - mx); const float inv = 1.f / (e0 + e1 + e2 + e3);
            lbs[j] = 0.f; lbs[512 + j] = e1 * inv; lbs[1024 + j] = (e1 + e2) * inv; lbs[1536 + j] = (e1 + e2 + e3) * inv; }
    }
}
__device__ __forceinline__ void phase_xcast(int wid0, int bid, const float* x, bf16_t* XB, float* ssq, int G) {
    const int tid = mk_tid(wid0); const int lane = tid & 63, gw = bid * 8 + (tid >> 6), NGW = G * 8;
    for (int m0 = gw * 2; m0 < MTOK; m0 += NGW * 2) { f32x4 v[2][4];
#pragma unroll
        for (int i = 0; i < 2; ++i) { const f32x4* xr = (const f32x4*)(x + (size_t)(m0 + i) * DM) + lane;
#pragma unroll
            for (int j = 0; j < 4; ++j) v[i][j] = xr[64 * j]; }
#pragma unroll
        for (int i = 0; i < 2; ++i) { const int m = m0 + i; u32x2* o8 = (u32x2*)(XB + (size_t)m * DM) + lane; float s = 0.f;
#pragma unroll
            for (int j = 0; j < 4; ++j) { const f32x4 vv = v[i][j]; s += (vv.x * vv.x + vv.y * vv.y) + (vv.z * vv.z + vv.w * vv.w); u32x2 w; w.x = pk2(vv.x, vv.y); w.y = pk2(vv.z, vv.w); o8[64 * j] = w; }
            s = wave_sum(s); if (lane < 16) ssq[(size_t)m * 16 + lane] = lane == 0 ? s : 0.f; } }
}
__device__ __forceinline__ void phase_zero(int wid0, int bid, float* p, int n, int G) { const int tid = mk_tid(wid0); for (int i = bid * 512 + tid; i < n; i += G * 512) p[i] = 0.f; }
__device__ __forceinline__ void phase_rmsnorm(int wid0, int bid, const float* x, const float* gain, bf16_t* H, int G) {
    const int tid = mk_tid(wid0);
    const int lane = tid & 63, gw = bid * 8 + (tid >> 6), NGW = G * 8;
    for (int m = gw; m < MTOK; m += NGW) rms_row_bf16(x + (size_t)m * DM, gain, H + (size_t)m * DM, lane);
}
__device__ __forceinline__ void phase_elem(int wid0, int bid, bf16_t* P, const float* qn, const float* kvn, const float* rope, bf16_t* KRP, int G) {
    const int tid = mk_tid(wid0);
    const int lane = tid & 63, gw = bid * 8 + (tid >> 6), NGW = G * 8;
    float gq[6], gk[4];
#pragma unroll
    for (int j = 0; j < 3; ++j) { gq[2 * j] = qn[2 * lane + 128 * j]; gq[2 * j + 1] = qn[2 * lane + 128 * j + 1]; }
#pragma unroll
    for (int j = 0; j < 2; ++j) { gk[2 * j] = kvn[2 * lane + 128 * j]; gk[2 * j + 1] = kvn[2 * lane + 128 * j + 1]; }
    for (int m0 = gw * 4; m0 < MTOK; m0 += NGW * 4) {
        unsigned wq[4][3], wk[4][2]; unsigned k1[4], k2[4]; float rc[4], rsn[4];
#pragma unroll
        for (int i = 0; i < 4; ++i) { bf16_t* row = P + (size_t)(m0 + i) * LDP; const unsigned* pq = (const unsigned*)(row + C_CQ) + lane; const unsigned* pk = (const unsigned*)(row + C_CKV) + lane;
#pragma unroll
            for (int j = 0; j < 3; ++j) wq[i][j] = pq[64 * j];
#pragma unroll
            for (int j = 0; j < 2; ++j) wk[i][j] = pk[64 * j];
            k1[i] = row[C_KR + (lane & 15)]; k2[i] = row[C_KR + 16 + (lane & 15)]; rc[i] = rope[(size_t)(m0 + i) * 32 + (lane & 15)]; rsn[i] = rope[(size_t)(m0 + i) * 32 + 16 + (lane & 15)]; }
#pragma unroll
        for (int i = 0; i < 4; ++i) { bf16_t* row = P + (size_t)(m0 + i) * LDP; unsigned* pq = (unsigned*)(row + C_CQ) + lane; unsigned* pk = (unsigned*)(row + C_CKV) + lane;
            float s = 0.f;
#pragma unroll
            for (int j = 0; j < 3; ++j) { const float a = bf2f(wq[i][j] & 0xffffu), b = bf2f(wq[i][j] >> 16); s += a * a + b * b; }
            const float rq = rsqrtf(wave_sum(s) * (1.f / 384.f) + EPS);
#pragma unroll
            for (int j = 0; j < 3; ++j) pq[64 * j] = pk2(bf2f(wq[i][j] & 0xffffu) * rq * gq[2 * j], bf2f(wq[i][j] >> 16) * rq * gq[2 * j + 1]);
            float s2 = 0.f;
#pragma unroll
            for (int j = 0; j < 2; ++j) { const float a = bf2f(wk[i][j] & 0xffffu), b = bf2f(wk[i][j] >> 16); s2 += a * a + b * b; }
            const float rk = rsqrtf(wave_sum(s2) * (1.f / 256.f) + EPS);
#pragma unroll
            for (int j = 0; j < 2; ++j) pk[64 * j] = pk2(bf2f(wk[i][j] & 0xffffu) * rk * gk[2 * j], bf2f(wk[i][j] >> 16) * rk * gk[2 * j + 1]);
            if (lane < 16) { const float x1 = bf2f(k1[i]), x2 = bf2f(k2[i]);
                KRP[(size_t)(m0 + i) * 32 + lane] = (bf16_t)f2bf(x1 * rc[i] - x2 * rsn[i]); KRP[(size_t)(m0 + i) * 32 + 16 + lane] = (bf16_t)f2bf(x2 * rc[i] + x1 * rsn[i]); } }
    }
}

__device__ __forceinline__ void hgrn_gate(float ff, float lb, float oml, float& logf, float& kk) {
    ff = fminf(fmaxf(ff, -30.f), 30.f);
    const float e = __expf(-ff), sg = __builtin_amdgcn_rcpf(1.f + e);
    logf = __logf(lb + oml * sg); kk = oml * e * sg;
}
__device__ __forceinline__ void hgrn_pass1(int wid0, int bid, unsigned char* lds, const bf16_t* P, const float* lbs, bf16_t* HST, float* HGD, int G) {
    bf16_t* KbT = (bf16_t*)lds; bf16_t* VT = (bf16_t*)(lds + 18432); float* tot = (float*)(lds + 36864);
    unsigned rf[16], rvv[16];
#define HG1_LOAD(uu, tid_) do { const int kc_ = (tid_) & 127, rg_ = (tid_) >> 7; const size_t r0_ = (size_t)((uu) >> 8) * SEQ + ((uu) & 63) * 64 + rg_ * 16; const bf16_t* p_ = P + r0_ * LDP + (((uu) >> 6) & 3) * 128 + kc_; \
        _Pragma("unroll") for (int r = 0; r < 16; ++r) { rf[r] = p_[(size_t)r * LDP + C_HF]; rvv[r] = p_[(size_t)r * LDP + C_HI]; } } while (0)
    if (bid < 2048) { const int t0 = mk_tid(wid0); HG1_LOAD(bid, t0); }
    for (int u = bid; u < 2048; u += G) {
        const int tid = mk_tid(wid0);
        const int lane = tid & 63, wid = tid >> 6, r32 = lane & 31, hh = lane >> 5, kc = tid & 127, rg = tid >> 7;
        const int h = (u >> 6) & 3;
        const float lb = lbs[h * 128 + kc], oml = 1.f - lb;
        float bb[16], kk[16]; unsigned vv[16]; float run = 0.f;
#pragma unroll
        for (int r = 0; r < 16; ++r) { const float ff = bf2f(rf[r]); vv[r] = rvv[r]; float lf; hgrn_gate(ff, lb, oml, lf, kk[r]); run += lf; bb[r] = run; }
        if (u + G < 2048) HG1_LOAD(u + G, tid);
        tot[rg * 128 + kc] = run; __syncthreads();
        float off = 0.f, blast = 0.f;
#pragma unroll
        for (int g = 0; g < 4; ++g) { const float t = tot[g * 128 + kc]; if (g < rg) off += t; blast += t; }
        unsigned kw[8], vw[8];
#pragma unroll
        for (int r = 0; r < 16; r += 2) { const float k0 = kk[r] * __expf(blast - (bb[r] + off)), k1 = kk[r + 1] * __expf(blast - (bb[r + 1] + off));
            kw[r >> 1] = pk2(k0, k1); vw[r >> 1] = vv[r] | (vv[r + 1] << 16); }
        *(u32x4*)(KbT + kc * 72 + rg * 16) = (u32x4){kw[0], kw[1], kw[2], kw[3]}; *(u32x4*)(KbT + kc * 72 + rg * 16 + 8) = (u32x4){kw[4], kw[5], kw[6], kw[7]};
        *(u32x4*)(VT + kc * 72 + rg * 16) = (u32x4){vw[0], vw[1], vw[2], vw[3]}; *(u32x4*)(VT + kc * 72 + rg * 16 + 8) = (u32x4){vw[4], vw[5], vw[6], vw[7]};
        if (rg == 0) HGD[u * 128 + kc] = __expf(blast);
        __syncthreads();
        const int kb = wid >> 1, vb0 = (wid & 1) * 2;
        f32x16 a0 = {}, a1 = {};
#pragma unroll
        for (int s = 0; s < 4; ++s) { const bf16x8 a = *(const bf16x8*)(KbT + (kb * 32 + r32) * 72 + 16 * s + 8 * hh);
            const bf16x8 b0 = *(const bf16x8*)(VT + (vb0 * 32 + r32) * 72 + 16 * s + 8 * hh), b1 = *(const bf16x8*)(VT + ((vb0 + 1) * 32 + r32) * 72 + 16 * s + 8 * hh);
            a0 = MFMA32(a, b0, a0); a1 = MFMA32(a, b1, a1); }
        bf16_t* st = HST + (size_t)u * 16384;
#pragma unroll
        for (int q = 0; q < 4; ++q) { u32x2 w0, w1; w0.x = cvt_pk_bf16(a0[4 * q], a0[4 * q + 1]); w0.y = cvt_pk_bf16(a0[4 * q + 2], a0[4 * q + 3]); w1.x = cvt_pk_bf16(a1[4 * q], a1[4 * q + 1]); w1.y = cvt_pk_bf16(a1[4 * q + 2], a1[4 * q + 3]);
            *(u32x2*)(st + (vb0 * 32 + r32) * 128 + kb * 32 + 8 * q + 4 * hh) = w0; *(u32x2*)(st + ((vb0 + 1) * 32 + r32) * 128 + kb * 32 + 8 * q + 4 * hh) = w1; }
        __syncthreads();
    }
}
__device__ __forceinline__ void hgrn_scan(int wid0, int bid, bf16_t* HST, const float* HGD, int G) {
    const int tid = mk_tid(wid0);
    for (int gt = bid * 512 + tid; gt < 131072; gt += G * 512) {
        const int e0 = gt * 4, bh = e0 >> 14, idx = e0 & 16383, k = idx & 127;
        float S0 = 0.f, S1 = 0.f, S2 = 0.f, S3 = 0.f;
#pragma unroll 16
        for (int c = 0; c < 64; ++c) { const int u = bh * 64 + c; u32x2* ptr = (u32x2*)(HST + (size_t)u * 16384 + idx); const u32x2 d = *ptr; const f32x4 dv = *(const f32x4*)(HGD + u * 128 + k);
            u32x2 w; w.x = pk2(S0, S1); w.y = pk2(S2, S3); *ptr = w;
            S0 = dv.x * S0 + bf2f(d.x & 0xffffu); S1 = dv.y * S1 + bf2f(d.x >> 16); S2 = dv.z * S2 + bf2f(d.y & 0xffffu); S3 = dv.w * S3 + bf2f(d.y >> 16); }
    }
}
__device__ __forceinline__ void hgrn_pass3(int wid0, int bid, unsigned char* lds, bf16_t* yo, int ypitch, bf16_t* P, const float* lbs, const float* ngain, const bf16_t* HST, int G) {
    bf16_t* QD = (bf16_t*)lds; bf16_t* KD = (bf16_t*)(lds + 17408); bf16_t* QB = (bf16_t*)(lds + 34816); bf16_t* QO = (bf16_t*)(lds + 52224); bf16_t* KO = (bf16_t*)(lds + 60928);
    bf16_t* VT = (bf16_t*)(lds + 69632); float* tot = (float*)(lds + 88064); float* ssq = (float*)(lds + 90112);
    unsigned rq[16], rf[16], rvv[16];
#define HG3_LOAD(uu, tid_) do { const int kc_ = (tid_) & 127, rg_ = (tid_) >> 7; const size_t r0_ = (size_t)((uu) >> 8) * SEQ + ((uu) & 63) * 64 + rg_ * 16; const bf16_t* p_ = P + r0_ * LDP + (((uu) >> 6) & 3) * 128 + kc_; \
        _Pragma("unroll") for (int r = 0; r < 16; ++r) { rq[r] = p_[(size_t)r * LDP + C_HQ]; rf[r] = p_[(size_t)r * LDP + C_HF]; rvv[r] = p_[(size_t)r * LDP + C_HI]; } } while (0)
    if (bid < 2048) { const int t0 = mk_tid(wid0); HG3_LOAD(bid, t0); }
    for (int u = bid; u < 2048; u += G) {
        const int tid = mk_tid(wid0);
        const int lane = tid & 63, wid = tid >> 6, r32 = lane & 31, hh = lane >> 5, kc = tid & 127, rg = tid >> 7;
        const int b = u >> 8, h = (u >> 6) & 3, c = u & 63;
        const size_t rowc = (size_t)b * SEQ + c * 64;
        const float lb = lbs[h * 128 + kc], oml = 1.f - lb;
        float bb[16], kk[16], qq[16]; unsigned vw[8]; float run = 0.f;
#pragma unroll
        for (int r = 0; r < 16; r += 2) {
            const float f0 = bf2f(rf[r]), f1 = bf2f(rf[r + 1]); vw[r >> 1] = rvv[r] | (rvv[r + 1] << 16);
            qq[r] = siluf_(bf2f(rq[r])); qq[r + 1] = siluf_(bf2f(rq[r + 1]));
            float lf; hgrn_gate(f0, lb, oml, lf, kk[r]); run += lf; bb[r] = run; hgrn_gate(f1, lb, oml, lf, kk[r + 1]); run += lf; bb[r + 1] = run; }
        if (u + G < 2048) HG3_LOAD(u + G, tid);
        u32x2 gpre[4];
        { const bf16_t* pg = P + (rowc + (wid >> 2) * 32 + r32) * LDP + C_HG + h * 128 + (wid & 3) * 32 + 4 * hh;
#pragma unroll
          for (int q = 0; q < 4; ++q) gpre[q] = *(const u32x2*)(pg + 8 * q); }
        bf16x8 spre[8];
        { const bf16_t* st = HST + (size_t)u * 16384 + ((wid & 3) * 32 + r32) * 128 + 8 * hh;
#pragma unroll
          for (int s8 = 0; s8 < 8; ++s8) spre[s8] = *(const bf16x8*)(st + 16 * s8); }
        tot[rg * 128 + kc] = run; __syncthreads();
        const float t0 = tot[kc], t1 = tot[128 + kc], t2 = tot[256 + kc];
        const float G0 = t0, G1 = t0 + t1, G2 = G1 + t2;
        const float off = rg == 0 ? 0.f : (rg == 1 ? G0 : (rg == 2 ? G1 : G2));
        const float refD = rg < 2 ? G0 : G2;
        *(u32x4*)(VT + kc * 72 + rg * 16) = (u32x4){vw[0], vw[1], vw[2], vw[3]}; *(u32x4*)(VT + kc * 72 + rg * 16 + 8) = (u32x4){vw[4], vw[5], vw[6], vw[7]};
        const float eD = __expf(refD), eO = rg >= 2 ? __expf(refD - G1) : __expf(G1 - refD);
#pragma unroll
        for (int r = 0; r < 16; ++r) { const int i = rg * 16 + r; const float bi = bb[r] + off;
            const float qe = qq[r] * __expf(fminf(bi - refD, 80.f)), ke = kk[r] * __expf(fminf(refD - bi, 80.f));
            QD[i * 136 + kc] = (bf16_t)f2bf(qe); KD[i * 136 + kc] = (bf16_t)f2bf(ke);
            QB[i * 136 + kc] = (bf16_t)f2bf(qe * eD);
            if (rg >= 2) QO[(i - 32) * 136 + kc] = (bf16_t)f2bf(qe * eO); else KO[i * 136 + kc] = (bf16_t)f2bf(ke * eO); }
        __syncthreads();
        const int vb = wid & 3, ib = wid >> 2;
        f32x16 o = {};
        {
#pragma unroll
          for (int s = 0; s < 8; ++s) { const bf16x8 a = spre[s]; const bf16x8 bq = *(const bf16x8*)(QB + (ib * 32 + r32) * 136 + 16 * s + 8 * hh); o = MFMA32(a, bq, o); } }
        { f32x16 at = {};
#pragma unroll
          for (int s = 0; s < 8; ++s) { const bf16x8 a = *(const bf16x8*)(KD + (ib * 32 + r32) * 136 + 16 * s + 8 * hh); const bf16x8 bq = *(const bf16x8*)(QD + (ib * 32 + r32) * 136 + 16 * s + 8 * hh); at = MFMA32(a, bq, at); }
#pragma unroll
          for (int r = 0; r < 16; ++r) if (crow(r, hh) > r32) at[r] = 0.f;
#pragma unroll
          for (int s2 = 0; s2 < 2; ++s2) { const bf16x8 bf = pack8(at, s2); const unsigned char* vp = (const unsigned char*)(VT + (vb * 32 + r32) * 72 + ib * 32 + 16 * s2 + 4 * hh);
              o = MFMA32(ld2x64(vp, vp + 16), bf, o); } }
        if (ib == 1) { f32x16 at = {};
#pragma unroll
          for (int s = 0; s < 8; ++s) { const bf16x8 a = *(const bf16x8*)(KO + r32 * 136 + 16 * s + 8 * hh); const bf16x8 bq = *(const bf16x8*)(QO + r32 * 136 + 16 * s + 8 * hh); at = MFMA32(a, bq, at); }
#pragma unroll
          for (int s2 = 0; s2 < 2; ++s2) { const bf16x8 bf = pack8(at, s2); const unsigned char* vp = (const unsigned char*)(VT + (vb * 32 + r32) * 72 + 16 * s2 + 4 * hh);
              o = MFMA32(ld2x64(vp, vp + 16), bf, o); } }
        float sq = 0.f;
#pragma unroll
        for (int r = 0; r < 16; ++r) sq += o[r] * o[r];
        sq += __shfl_xor(sq, 32);
        if (hh == 0) ssq[(ib * 32 + r32) * 4 + vb] = sq;
        __syncthreads();
        const f32x4 sv = *(const f32x4*)(ssq + (ib * 32 + r32) * 4);
        const float rstd = rsqrtf((sv.x + sv.y + sv.z + sv.w) * (1.f / 128.f) + EPS);
        bf16_t* prow = P + (rowc + ib * 32 + r32) * LDP;
#pragma unroll
        for (int q = 0; q < 4; ++q) { const int v0 = h * 128 + vb * 32 + 8 * q + 4 * hh; const u32x2 gw = gpre[q]; const f32x4 ng = *(const f32x4*)(ngain + v0);
            const float y0 = o[4 * q] * rstd * ng.x * siluf_(bf2f(gw.x & 0xffffu)), y1 = o[4 * q + 1] * rstd * ng.y * siluf_(bf2f(gw.x >> 16));
            const float y2 = o[4 * q + 2] * rstd * ng.z * siluf_(bf2f(gw.y & 0xffffu)), y3 = o[4 * q + 3] * rstd * ng.w * siluf_(bf2f(gw.y >> 16));
            u32x2 w; w.x = pk2(y0, y1); w.y = pk2(y2, y3); *(u32x2*)(yo + (rowc + ib * 32 + r32) * ypitch + v0) = w; }
        __syncthreads();
    }
}

__device__ __forceinline__ float softplusf_(float x) { if (x > 15.f) return x; const float e = __expf(x); return e < 1e-3f ? e * (1.f - 0.5f * e) : __logf(1.f + e); }
__device__ __forceinline__ void mamba_dt(int tid, const bf16_t* P, size_t row0, int g, const float* dt_bias, const float* a_log, float* dtv, float* acum, float* wtot) {
    const int lane = tid & 63, wid = tid >> 6; const int hl = wid >> 1, l = (wid & 1) * 64 + lane, head = g * 4 + hl;
    const float dt = softplusf_(bf2f(P[(row0 + l) * LDP + C_DT + head]) + dt_bias[head]);
    float v = -__expf(a_log[head]) * dt;
#pragma unroll
    for (int o = 1; o < 64; o <<= 1) { const float t = __shfl_up(v, o); if (lane >= o) v += t; }
    if (lane == 63) wtot[wid] = v;
    __syncthreads();
    if (wid & 1) v += wtot[wid - 1];
    acum[hl * 128 + l] = v; dtv[hl * 128 + l] = dt;
    __syncthreads();
}
__device__ __forceinline__ void mamba_pass1(int wid0, int bid, unsigned char* lds, const bf16_t* P, const float* cw, const float* cb, const float* dt_bias, const float* a_log, bf16_t* MS, float* MAT, int G) {
    bf16_t* XwT = (bf16_t*)lds; bf16_t* BT = (bf16_t*)(lds + 69632); float* dtv = (float*)(lds + 87040); float* acum = (float*)(lds + 89088); float* wtot = (float*)(lds + 91136);
    for (int u = bid; u < 512; u += G) {
        const int tid = mk_tid(wid0);
        const int lane = tid & 63, wid = tid >> 6, r32 = lane & 31, hh = lane >> 5;
        const int b = u >> 6, c = (u >> 1) & 31, g = u & 1; const size_t row0 = (size_t)b * SEQ + c * 128;
        const int ch = tid & 255, rh = tid >> 8, chanx = g * 256 + ch, hlx = ch >> 6, lx0 = rh * 64;
        const bf16_t* pxx = P + row0 * LDP + C_XBC + chanx; const int tokx = c * 128 + lx0;
        unsigned rx[64]; unsigned hx3 = 0, hx2 = 0, hx1 = 0;
        if (tokx >= 3) { hx3 = pxx[(ptrdiff_t)(lx0 - 3) * LDP]; hx2 = pxx[(ptrdiff_t)(lx0 - 2) * LDP]; hx1 = pxx[(ptrdiff_t)(lx0 - 1) * LDP]; }
#pragma unroll
        for (int i = 0; i < 64; ++i) rx[i] = pxx[(size_t)(lx0 + i) * LDP];
        const int nB = tid & 63, rgp = tid >> 6, chanb = 512 + g * 64 + nB, lb0 = rgp * 16;
        const bf16_t* pxb = P + row0 * LDP + C_XBC + chanb; const int tokb = c * 128 + lb0;
        unsigned rb[16]; unsigned hb3 = 0, hb2 = 0, hb1 = 0;
        if (tokb >= 3) { hb3 = pxb[(ptrdiff_t)(lb0 - 3) * LDP]; hb2 = pxb[(ptrdiff_t)(lb0 - 2) * LDP]; hb1 = pxb[(ptrdiff_t)(lb0 - 1) * LDP]; }
#pragma unroll
        for (int i = 0; i < 16; ++i) rb[i] = pxb[(size_t)(lb0 + i) * LDP];
        const float wx0 = cw[chanx], wx1 = cw[768 + chanx], wx2 = cw[1536 + chanx], wx3 = cw[2304 + chanx], bx = cb[chanx];
        const float wb0 = cw[chanb], wb1 = cw[768 + chanb], wb2 = cw[1536 + chanb], wb3 = cw[2304 + chanb], bbv = cb[chanb];
        mamba_dt(tid, P, row0, g, dt_bias, a_log, dtv, acum, wtot);
        { float x3 = bf2f(hx3), x2 = bf2f(hx2), x1 = bf2f(hx1); const float alast = acum[hlx * 128 + 127];
#pragma unroll
          for (int k8 = 0; k8 < 8; ++k8) { unsigned w[4];
#pragma unroll
              for (int e = 0; e < 8; e += 2) { float xv[2];
#pragma unroll
                  for (int e2 = 0; e2 < 2; ++e2) { const int l = lx0 + k8 * 8 + e + e2; const float xin = bf2f(rx[k8 * 8 + e + e2]); const float cv = wx0 * x3 + wx1 * x2 + wx2 * x1 + wx3 * xin + bx; x3 = x2; x2 = x1; x1 = xin;
                      xv[e2] = siluf_(cv) * dtv[hlx * 128 + l] * __expf(alast - acum[hlx * 128 + l]); }
                  w[e >> 1] = pk2(xv[0], xv[1]); }
              *(u32x4*)(XwT + ch * 136 + lx0 + k8 * 8) = (u32x4){w[0], w[1], w[2], w[3]}; } }
        { float x3 = bf2f(hb3), x2 = bf2f(hb2), x1 = bf2f(hb1); unsigned w[8];
#pragma unroll
          for (int e = 0; e < 16; e += 2) { float xv[2];
#pragma unroll
              for (int e2 = 0; e2 < 2; ++e2) { const float xin = bf2f(rb[e + e2]); const float cv = wb0 * x3 + wb1 * x2 + wb2 * x1 + wb3 * xin + bbv; x3 = x2; x2 = x1; x1 = xin; xv[e2] = siluf_(cv); }
              w[e >> 1] = pk2(xv[0], xv[1]); }
          *(u32x4*)(BT + nB * 136 + lb0) = (u32x4){w[0], w[1], w[2], w[3]}; *(u32x4*)(BT + nB * 136 + lb0 + 8) = (u32x4){w[4], w[5], w[6], w[7]}; }
        __syncthreads();
        { const int hl = wid >> 1, nb = wid & 1, head = g * 4 + hl;
          f32x16 a0 = {}, a1 = {};
#pragma unroll
          for (int s = 0; s < 8; ++s) { const bf16x8 a = *(const bf16x8*)(BT + (nb * 32 + r32) * 136 + 16 * s + 8 * hh);
              const bf16x8 b0 = *(const bf16x8*)(XwT + (hl * 64 + r32) * 136 + 16 * s + 8 * hh), b1 = *(const bf16x8*)(XwT + (hl * 64 + 32 + r32) * 136 + 16 * s + 8 * hh);
              a0 = MFMA32(a, b0, a0); a1 = MFMA32(a, b1, a1); }
          bf16_t* ms = MS + (size_t)((b * 32 + c) * 8 + head) * 4096;
#pragma unroll
          for (int q = 0; q < 4; ++q) { u32x2 w0, w1; w0.x = cvt_pk_bf16(a0[4 * q], a0[4 * q + 1]); w0.y = cvt_pk_bf16(a0[4 * q + 2], a0[4 * q + 3]); w1.x = cvt_pk_bf16(a1[4 * q], a1[4 * q + 1]); w1.y = cvt_pk_bf16(a1[4 * q + 2], a1[4 * q + 3]);
              *(u32x2*)(ms + r32 * 64 + nb * 32 + 8 * q + 4 * hh) = w0; *(u32x2*)(ms + (32 + r32) * 64 + nb * 32 + 8 * q + 4 * hh) = w1; }
          if (tid < 4) MAT[(b * 32 + c) * 8 + g * 4 + tid] = acum[tid * 128 + 127]; }
        __syncthreads();
    }
}
__device__ __forceinline__ void mamba_scan(int wid0, int bid, bf16_t* MS, const float* MAT, int G) {
    const int tid = mk_tid(wid0);
    for (int gt = bid * 512 + tid; gt < 65536; gt += G * 512) {
        const int e0 = gt * 4, bhd = e0 >> 12, b = bhd >> 3, head = bhd & 7, idx = e0 & 4095;
        float S0 = 0.f, S1 = 0.f, S2 = 0.f, S3 = 0.f;
#pragma unroll 16
        for (int c = 0; c < 32; ++c) { const int ui = (b * 32 + c) * 8 + head; u32x2* ptr = (u32x2*)(MS + (size_t)ui * 4096 + idx); const u32x2 d = *ptr; const float dec = __expf(MAT[ui]);
            u32x2 w; w.x = pk2(S0, S1); w.y = pk2(S2, S3); *ptr = w;
            S0 = dec * S0 + bf2f(d.x & 0xffffu); S1 = dec * S1 + bf2f(d.x >> 16); S2 = dec * S2 + bf2f(d.y & 0xffffu); S3 = dec * S3 + bf2f(d.y >> 16); }
    }
}
__device__ __forceinline__ void mamba_pass3(int wid0, int bid, unsigned char* lds, bf16_t* yo, int ypitch, bf16_t* P, const float* cw, const float* cb, const float* dt_bias, const float* a_log, const float* dsk, const float* ngain, const bf16_t* MS, int G) {
    bf16_t* XT = (bf16_t*)lds; bf16_t* Brow = (bf16_t*)(lds + 69632); bf16_t* Crow = (bf16_t*)(lds + 88064);
    float* dtv = (float*)(lds + 106496); float* acum = (float*)(lds + 108544); float* ssq = (float*)(lds + 110592); float* wtot = (float*)(lds + 111616);
    for (int u = bid; u < 512; u += G) {
        const int tid = mk_tid(wid0);
        const int lane = tid & 63, wid = tid >> 6, r32 = lane & 31, hh = lane >> 5;
        const int b = u >> 6, c = (u >> 1) & 31, g = u & 1; const size_t row0 = (size_t)b * SEQ + c * 128;
        const int ch = tid & 255, rh = tid >> 8, chanx = g * 256 + ch, lx0 = rh * 64;
        const bf16_t* pxx = P + row0 * LDP + C_XBC + chanx; const int tokx = c * 128 + lx0;
        unsigned rx[64]; unsigned hx3 = 0, hx2 = 0, hx1 = 0;
        if (tokx >= 3) { hx3 = pxx[(ptrdiff_t)(lx0 - 3) * LDP]; hx2 = pxx[(ptrdiff_t)(lx0 - 2) * LDP]; hx1 = pxx[(ptrdiff_t)(lx0 - 1) * LDP]; }
#pragma unroll
        for (int i = 0; i < 64; ++i) rx[i] = pxx[(size_t)(lx0 + i) * LDP];
        const int nB = tid & 63, rgp = tid >> 6, lb0 = rgp * 16; const int tokb = c * 128 + lb0;
        const bf16_t* pxb = P + row0 * LDP + C_XBC + 512 + g * 64 + nB;
        unsigned rb[2][16]; unsigned hb[2][3] = {{0, 0, 0}, {0, 0, 0}};
#pragma unroll
        for (int wh = 0; wh < 2; ++wh) {
            if (tokb >= 3) { hb[wh][0] = pxb[(ptrdiff_t)(lb0 - 3) * LDP + wh * 128]; hb[wh][1] = pxb[(ptrdiff_t)(lb0 - 2) * LDP + wh * 128]; hb[wh][2] = pxb[(ptrdiff_t)(lb0 - 1) * LDP + wh * 128]; }
#pragma unroll
            for (int i = 0; i < 16; ++i) rb[wh][i] = pxb[(size_t)(lb0 + i) * LDP + wh * 128]; }
        const float wx0 = cw[chanx], wx1 = cw[768 + chanx], wx2 = cw[1536 + chanx], wx3 = cw[2304 + chanx], bx = cb[chanx];
        mamba_dt(tid, P, row0, g, dt_bias, a_log, dtv, acum, wtot);
        { float x3 = bf2f(hx3), x2 = bf2f(hx2), x1 = bf2f(hx1);
#pragma unroll
          for (int k8 = 0; k8 < 8; ++k8) { unsigned w[4];
#pragma unroll
              for (int e = 0; e < 8; e += 2) { float xv[2];
#pragma unroll
                  for (int e2 = 0; e2 < 2; ++e2) { const float xin = bf2f(rx[k8 * 8 + e + e2]); const float cv = wx0 * x3 + wx1 * x2 + wx2 * x1 + wx3 * xin + bx; x3 = x2; x2 = x1; x1 = xin; xv[e2] = siluf_(cv); }
                  w[e >> 1] = pk2(xv[0], xv[1]); }
              *(u32x4*)(XT + ch * 136 + lx0 + k8 * 8) = (u32x4){w[0], w[1], w[2], w[3]}; } }
#pragma unroll
        for (int wh = 0; wh < 2; ++wh) { const int chan = 512 + wh * 128 + g * 64 + nB; bf16_t* dst = wh ? Crow : Brow;
            const float w0 = cw[chan], w1 = cw[768 + chan], w2 = cw[1536 + chan], w3 = cw[2304 + chan], bias = cb[chan];
            float x3 = bf2f(hb[wh][0]), x2 = bf2f(hb[wh][1]), x1 = bf2f(hb[wh][2]);
#pragma unroll
            for (int e = 0; e < 16; ++e) { const float xin = bf2f(rb[wh][e]); const float cv = w0 * x3 + w1 * x2 + w2 * x1 + w3 * xin + bias; x3 = x2; x2 = x1; x1 = xin;
                dst[(lb0 + e) * 72 + nB] = (bf16_t)f2bf(siluf_(cv)); } }
        __syncthreads();
        const int lblk = wid & 3, hp = wid >> 2;
        f32x16 y[2][2] = {};
        for (int sb = 0; sb <= lblk; ++sb) {
            f32x16 gt = {};
#pragma unroll
            for (int s = 0; s < 4; ++s) { const bf16x8 a = *(const bf16x8*)(Brow + (sb * 32 + r32) * 72 + 16 * s + 8 * hh); const bf16x8 bq = *(const bf16x8*)(Crow + (lblk * 32 + r32) * 72 + 16 * s + 8 * hh); gt = MFMA32(a, bq, gt); }
#pragma unroll
            for (int hi2 = 0; hi2 < 2; ++hi2) { const int hl = 2 * hp + hi2; const float al = acum[hl * 128 + lblk * 32 + r32]; const float dk = dsk[g * 4 + hl];
                f32x16 m;
#pragma unroll
                for (int r = 0; r < 16; ++r) { const int sl = crow(r, hh); const float v = gt[r] * __expf(al - acum[hl * 128 + sb * 32 + sl]) * dtv[hl * 128 + sb * 32 + sl];
                    m[r] = (sb < lblk || sl < r32) ? v : (sl == r32 ? v + dk : 0.f); }
#pragma unroll
                for (int s2 = 0; s2 < 2; ++s2) { const bf16x8 bf = pack8(m, s2);
#pragma unroll
                    for (int pb = 0; pb < 2; ++pb) { const unsigned char* xp = (const unsigned char*)(XT + (hl * 64 + pb * 32 + r32) * 136 + sb * 32 + 16 * s2 + 4 * hh); y[hi2][pb] = MFMA32(ld2x64(xp, xp + 16), bf, y[hi2][pb]); } } asm volatile("" ::: "memory"); }
        }
#pragma unroll
        for (int hi2 = 0; hi2 < 2; ++hi2) { const int hl = 2 * hp + hi2, head = g * 4 + hl; const float ea = __expf(acum[hl * 128 + lblk * 32 + r32]);
#pragma unroll
            for (int pb = 0; pb < 2; ++pb) { f32x16 t = {}; const bf16_t* sp = MS + ((size_t)((b * 32 + c) * 8 + head) * 64 + pb * 32 + r32) * 64;
#pragma unroll
                for (int s = 0; s < 4; ++s) { const bf16x8 a = *(const bf16x8*)(sp + 16 * s + 8 * hh); const bf16x8 bq = *(const bf16x8*)(Crow + (lblk * 32 + r32) * 72 + 16 * s + 8 * hh); t = MFMA32(a, bq, t); }
#pragma unroll
                for (int r = 0; r < 16; ++r) y[hi2][pb][r] += t[r] * ea; asm volatile("" ::: "memory"); } }
        bf16_t* prow = P + (row0 + lblk * 32 + r32) * LDP;
        float sq = 0.f;
#pragma unroll
        for (int hi2 = 0; hi2 < 2; ++hi2)
#pragma unroll
            for (int pb = 0; pb < 2; ++pb)
#pragma unroll
                for (int q = 0; q < 4; ++q) { const int chl = g * 256 + (2 * hp + hi2) * 64 + pb * 32 + 8 * q + 4 * hh; const u32x2 zw = *(const u32x2*)(prow + C_SZ + chl);
                    y[hi2][pb][4 * q] *= siluf_(bf2f(zw.x & 0xffffu)); y[hi2][pb][4 * q + 1] *= siluf_(bf2f(zw.x >> 16)); y[hi2][pb][4 * q + 2] *= siluf_(bf2f(zw.y & 0xffffu)); y[hi2][pb][4 * q + 3] *= siluf_(bf2f(zw.y >> 16));
#pragma unroll
                    for (int e = 0; e < 4; ++e) sq += y[hi2][pb][4 * q + e] * y[hi2][pb][4 * q + e]; if (q & 1) asm volatile("" ::: "memory"); }
        sq += __shfl_xor(sq, 32);
        if (hh == 0) ssq[(lblk * 32 + r32) * 2 + hp] = sq;
        __syncthreads();
        const float rstd = rsqrtf((ssq[(lblk * 32 + r32) * 2] + ssq[(lblk * 32 + r32) * 2 + 1]) * (1.f / 256.f) + EPS);
#pragma unroll
        for (int hi2 = 0; hi2 < 2; ++hi2)
#pragma unroll
            for (int pb = 0; pb < 2; ++pb)
#pragma unroll
                for (int q = 0; q < 4; ++q) { const int chl = g * 256 + (2 * hp + hi2) * 64 + pb * 32 + 8 * q + 4 * hh; const f32x4 ng = *(const f32x4*)(ngain + chl);
                    u32x2 w; w.x = pk2(y[hi2][pb][4 * q] * rstd * ng.x, y[hi2][pb][4 * q + 1] * rstd * ng.y); w.y = pk2(y[hi2][pb][4 * q + 2] * rstd * ng.z, y[hi2][pb][4 * q + 3] * rstd * ng.w);
                    *(u32x2*)(yo + (row0 + lblk * 32 + r32) * ypitch + chl) = w; if (q & 1) asm volatile("" ::: "memory"); }
        __syncthreads();
    }
}

constexpr int AT_KB = 26624, AT_VB = 17408, AT_VOFF = 2 * AT_KB, AT_VP = 132;
__device__ __forceinline__ void attn_pv(f32x16& o0, f32x16& o1, const bf16x8 (&pp)[8], const bf16_t* Vs, int r32, int hh) {
#pragma unroll
    for (int s = 0; s < 8; ++s) { const unsigned char* v0 = (const unsigned char*)(Vs + r32 * AT_VP + 16 * s + 4 * hh); const unsigned char* v1 = (const unsigned char*)(Vs + (32 + r32) * AT_VP + 16 * s + 4 * hh);
        o0 = MFMA32(ld2x64(v0, v0 + 16), pp[s], o0); o1 = MFMA32(ld2x64(v1, v1 + 16), pp[s], o1); }
}
__device__ __forceinline__ void attn_unit(int tid, unsigned char* lds, int b, int h, int qb, const bf16_t* Q, const bf16_t* KN, const bf16_t* KRP, const bf16_t* VT, bf16_t* P) {
    const int lane = tid & 63, wid = tid >> 6, r32 = lane & 31, hh = lane >> 5;
    const bool grpB = false;
    const size_t rowb = (size_t)b * SEQ; const int q0 = qb * 256, qw0 = q0 + wid * 32;
    bf16x8 qf[6];
    { const bf16_t* qp = Q + (rowb + qw0 + r32) * 768 + h * 96 + 8 * hh;
#pragma unroll
      for (int s = 0; s < 6; ++s) qf[s] = *(const bf16x8*)(qp + 16 * s); }
    const int NT = (q0 + 256) / 128, ntw = (qw0 + 31) / 128 + 1;
    const bf16_t* kp = KN + (rowb + (tid >> 3)) * 512 + h * 64 + (tid & 7) * 8;
    const bf16_t* rp = KRP + (rowb + (tid >> 2)) * 32 + (tid & 3) * 8;
    const bf16_t* vp = VT + ((size_t)((b * 8 + h) * 64 + (tid >> 3))) * SEQ + (tid & 7) * 8;
    u32x4 k0r, k1r, rr, v0r, v1r;
#define AT_LD(tt) do { k0r = *(const u32x4*)(kp + (size_t)(tt) * 128 * 512); k1r = *(const u32x4*)(kp + ((size_t)(tt) * 128 + 64) * 512); rr = *(const u32x4*)(rp + (size_t)(tt) * 128 * 32); \
        v0r = *(const u32x4*)(vp + (tt) * 128); v1r = *(const u32x4*)(vp + (tt) * 128 + 64); } while (0)
#define AT_ST(kb, vb) do { bf16_t* Kw = (bf16_t*)(lds + AT_KB * (kb)); bf16_t* Vw = (bf16_t*)(lds + AT_VOFF + AT_VB * (vb)); \
        *(u32x4*)(Kw + (tid >> 3) * 104 + (tid & 7) * 8) = k0r; *(u32x4*)(Kw + (64 + (tid >> 3)) * 104 + (tid & 7) * 8) = k1r; *(u32x4*)(Kw + (tid >> 2) * 104 + 64 + (tid & 3) * 8) = rr; \
        bf16_t* vr = Vw + (tid >> 3) * AT_VP + (tid & 7) * 8; *(u32x2*)vr = (u32x2){v0r.x, v0r.y}; *(u32x2*)(vr + 4) = (u32x2){v0r.z, v0r.w}; *(u32x2*)(vr + 64) = (u32x2){v1r.x, v1r.y}; *(u32x2*)(vr + 68) = (u32x2){v1r.z, v1r.w}; } while (0)
    AT_LD(0);
    float mrun = -INFINITY, lrun = 0.f; f32x16 o0 = {}, o1 = {};
    const int qpos = qw0 + r32;
    bf16x8 pp[8] = {};
    AT_ST(0, 0);
    int vcur = 0, vprev = 2;
    if (NT > 1) AT_LD(1);
    __syncthreads();
    for (int t = 0; t < NT; ++t) {
        const int vnext = (vcur == 2) ? 0 : vcur + 1;
        if (t + 1 < NT) AT_ST((t + 1) & 1, vnext);
        if (t + 2 < NT) AT_LD(t + 2);
        const bf16_t* Ks = (const bf16_t*)(lds + AT_KB * (t & 1)); const bf16_t* Vs = (const bf16_t*)(lds + AT_VOFF + AT_VB * vcur);
        if (grpB && t > 0 && t - 1 < ntw) attn_pv(o0, o1, pp, (const bf16_t*)(lds + AT_VOFF + AT_VB * vprev), r32, hh);
        if (t < ntw) {
            f32x16 p[4] = {};
#pragma unroll
            for (int s = 0; s < 6; ++s)
#pragma unroll
                for (int blk = 0; blk < 4; ++blk) { const bf16x8 a = *(const bf16x8*)(Ks + (32 * blk + r32) * 104 + 16 * s + 8 * hh); p[blk] = MFMA32(a, qf[s], p[blk]); }
            if (t * 128 + 127 > qw0) {
#pragma unroll
                for (int blk = 0; blk < 4; ++blk)
#pragma unroll
                    for (int r = 0; r < 16; ++r) { const int kv = t * 128 + 32 * blk + crow(r, hh); if (kv > qpos) p[blk][r] = -INFINITY; } }
            float rm0 = fmaxf(fmaxf(p[0][0], p[1][0]), fmaxf(p[2][0], p[3][0])), rm1 = fmaxf(fmaxf(p[0][1], p[1][1]), fmaxf(p[2][1], p[3][1]));
            float rm2 = fmaxf(fmaxf(p[0][2], p[1][2]), fmaxf(p[2][2], p[3][2])), rm3 = fmaxf(fmaxf(p[0][3], p[1][3]), fmaxf(p[2][3], p[3][3]));
#pragma unroll
            for (int r = 4; r < 16; r += 4) {
                rm0 = fmaxf(rm0, fmaxf(fmaxf(p[0][r], p[1][r]), fmaxf(p[2][r], p[3][r]))); rm1 = fmaxf(rm1, fmaxf(fmaxf(p[0][r + 1], p[1][r + 1]), fmaxf(p[2][r + 1], p[3][r + 1])));
                rm2 = fmaxf(rm2, fmaxf(fmaxf(p[0][r + 2], p[1][r + 2]), fmaxf(p[2][r + 2], p[3][r + 2]))); rm3 = fmaxf(rm3, fmaxf(fmaxf(p[0][r + 3], p[1][r + 3]), fmaxf(p[2][r + 3], p[3][r + 3]))); }
            float rm = fmaxf(fmaxf(rm0, rm1), fmaxf(rm2, rm3));
            rm = fmaxf(rm, __shfl_xor(rm, 32));
            const float mnew = fmaxf(mrun, rm);
            if (__any(mnew > mrun)) {
                const float alpha = __builtin_amdgcn_exp2f(mrun - mnew); lrun *= alpha;
#pragma unroll
                for (int r = 0; r < 16; ++r) { o0[r] *= alpha; o1[r] *= alpha; } }
            mrun = mnew;
            float ps0 = 0.f, ps1 = 0.f, ps2 = 0.f, ps3 = 0.f;
#pragma unroll
            for (int blk = 0; blk < 4; ++blk) {
#pragma unroll
                for (int r = 0; r < 16; r += 4) {
                    p[blk][r] = __builtin_amdgcn_exp2f(p[blk][r] - mnew); ps0 += p[blk][r]; p[blk][r + 1] = __builtin_amdgcn_exp2f(p[blk][r + 1] - mnew); ps1 += p[blk][r + 1];
                    p[blk][r + 2] = __builtin_amdgcn_exp2f(p[blk][r + 2] - mnew); ps2 += p[blk][r + 2]; p[blk][r + 3] = __builtin_amdgcn_exp2f(p[blk][r + 3] - mnew); ps3 += p[blk][r + 3]; }
                pp[2 * blk] = pack8(p[blk], 0); pp[2 * blk + 1] = pack8(p[blk], 1); }
            lrun += (ps0 + ps1) + (ps2 + ps3);
            if (!grpB) attn_pv(o0, o1, pp, Vs, r32, hh);
        }
        __syncthreads();
        vprev = vcur; vcur = vnext;
    }
#undef AT_LD
#undef AT_ST
    if (grpB && NT - 1 < ntw) attn_pv(o0, o1, pp, (const bf16_t*)(lds + AT_VOFF + AT_VB * vprev), r32, hh);
    lrun += __shfl_xor(lrun, 32);
    const float il = 1.f / lrun;
    bf16_t* orow = P + (rowb + qpos) * LDP + C_YB + h * 64;
#pragma unroll
    for (int q = 0; q < 4; ++q) { u32x2 w0, w1; w0.x = pk2(o0[4 * q] * il, o0[4 * q + 1] * il); w0.y = pk2(o0[4 * q + 2] * il, o0[4 * q + 3] * il); w1.x = pk2(o1[4 * q] * il, o1[4 * q + 1] * il); w1.y = pk2(o1[4 * q + 2] * il, o1[4 * q + 3] * il);
        *(u32x2*)(orow + 8 * q + 4 * hh) = w0; *(u32x2*)(orow + 32 + 8 * q + 4 * hh) = w1; }
    __syncthreads();
}
__device__ __forceinline__ void phase_attn(int wid0, int bid, unsigned char* lds, const bf16_t* Q, const bf16_t* KN, const bf16_t* KRP, const bf16_t* VT, bf16_t* P, int G) {
    const int tid = mk_tid(wid0);
    if (G == 256) { const int bx = bid, vcu = (bx % 8) * 32 + bx / 8, bh = vcu >> 2, s = vcu & 3;
        for (int i = 0; i < 4; ++i) { const int qb = (i == 0) ? 15 - s : (i == 1) ? s : (i == 2) ? 8 + s : 7 - s; attn_unit(tid, lds, bh >> 3, bh & 7, qb, Q, KN, KRP, VT, P); } }
    else for (int u = bid; u < 1024; u += G) attn_unit(tid, lds, u >> 7, (u >> 4) & 7, 15 - (u & 15), Q, KN, KRP, VT, P);
}

#define XB_TMO      128
#define XB_XCNT(j)  (256  + 64 * (j))
#define XB_XSUB(j)  (1280 + 64 * (j))
#define XB_XGEN(j)  (2304 + 64 * (j))
#define XB_TOP      3328
#define XB_TOPGEN   3392
#define XCD_BAR_WORDS 3456
#define XB_SPIN_CAP (1u << 20)
__device__ __forceinline__ unsigned xb_ld(unsigned* p)              { return __hip_atomic_load(p, __ATOMIC_RELAXED, __HIP_MEMORY_SCOPE_AGENT); }
__device__ __forceinline__ unsigned xb_add(unsigned* p, unsigned v) { return __hip_atomic_fetch_add(p, v, __ATOMIC_RELAXED, __HIP_MEMORY_SCOPE_AGENT); }
__device__ __forceinline__ unsigned xb_xcc_id() { return (unsigned)__builtin_amdgcn_s_getreg((3 << 11) | 20) & 0xFu; }
#define XB_SPIN(cond, bar) do { unsigned _sp = 0; while (cond) { __builtin_amdgcn_s_sleep(1); \
    if ((++_sp & 255u) == 0u) { if (xb_ld(&(bar)[XB_TMO])) break; if (_sp > XB_SPIN_CAP) { atomicAdd(&(bar)[XB_TMO], 1u); break; } } } } while (0)
__device__ __forceinline__ void xcd_barrier_complete(unsigned* bar, unsigned x, unsigned G, unsigned& nloc, unsigned& nx) {
    unsigned sum, cnt, mine, sp = 0u;
    for (;;) {
        sum = 0u; cnt = 0u; mine = 0u;
#pragma unroll
        for (unsigned j = 0; j < 16; ++j) { const unsigned c = xb_ld(&bar[XB_XCNT(j)]); sum += c; cnt += (c > 0u) ? 1u : 0u; mine = (j == x) ? c : mine; }
        if (sum == G) break;
        __builtin_amdgcn_s_sleep(1);
        if ((++sp & 255u) == 0u) { if (xb_ld(&bar[XB_TMO])) break; if (sp > XB_SPIN_CAP) { atomicAdd(&bar[XB_TMO], 1u); break; } }
    }
    nloc = mine > 0u ? mine : 1u; nx = cnt > 0u ? cnt : 1u;
}
__device__ __forceinline__ void xcd_barrier(unsigned* bar, volatile LAS unsigned* st, bool leader_thread, unsigned G) {
    asm volatile("s_waitcnt vmcnt(0)" ::: "memory");
    __syncthreads();
    if (leader_thread) {
        const unsigned x = xb_xcc_id();
        __builtin_amdgcn_s_waitcnt(0);
        unsigned nloc = st[0], nx = st[1];
        if (nloc == 0u) { xcd_barrier_complete(bar, x, G, nloc, nx); st[0] = nloc; st[1] = nx; }
        const unsigned old = xb_add(&bar[XB_XSUB(x)], 1u);
        const unsigned gen = old / nloc;
        if (old + 1u == (gen + 1u) * nloc) {
            __builtin_amdgcn_fence(__ATOMIC_RELEASE, "agent");
            asm volatile("s_waitcnt vmcnt(0)" ::: "memory");
            const unsigned og = xb_add(&bar[XB_TOP], 1u);
            const unsigned tg = og / nx;
            if (og + 1u == (tg + 1u) * nx) xb_add(&bar[XB_TOPGEN], 1u);
            else XB_SPIN(xb_ld(&bar[XB_TOPGEN]) == tg, bar);
            __builtin_amdgcn_fence(__ATOMIC_ACQUIRE, "agent");
            xb_add(&bar[XB_XGEN(x)], 1u);
            asm volatile("s_waitcnt vmcnt(0)" ::: "memory");
        } else {
            XB_SPIN(xb_ld(&bar[XB_XGEN(x)]) == gen, bar);
            __builtin_amdgcn_fence(__ATOMIC_ACQUIRE, "agent");
            asm volatile("s_waitcnt vmcnt(0)" ::: "memory");
        }
    }
    __syncthreads();
}
#ifndef DUP_SEQ
#define DUP_SEQ 0
#endif
#if DUP_SEQ == 1
constexpr int PH_PER_LAYER = 22;
__host__ __device__ __forceinline__ int step_k(int s, int& flag) { flag = (s == 4); return s < 4 ? s : (s < 6 ? s - 2 : s - 2); }
#elif DUP_SEQ == 2
constexpr int PH_PER_LAYER = 22;
__host__ __device__ __forceinline__ int step_k(int s, int& flag) { flag = (s == 4 || s == 5); return s < 4 ? s : s - 2; }
#else
constexpr int PH_PER_LAYER = 20;
__host__ __device__ __forceinline__ int step_k(int s, int& flag) { flag = 0; return s; }
#endif
__host__ __device__ __forceinline__ bool k_nosync(int k) { return k == 5 || k == 7 || k == 8 || (k >= 11 && k <= 15) || k == 17; }
constexpr int LDS_BYTES = 147456, PH_TOTAL = DEPTH * PH_PER_LAYER + 1;
__global__ void __launch_bounds__(512, 2) fwd_mega(Args Aarg) {
    extern __shared__ __attribute__((aligned(16))) unsigned char lds[];
    cg::grid_group grid = cg::this_grid();
    const int G = gridDim.x;
    LAS unsigned char* ldsl = (LAS unsigned char*)lds;
    const int ph_lo = Aarg.ph_lo, ph_hi = Aarg.ph_hi;
    if (ph_lo < 0) grid.sync();
    const int wid0 = __builtin_amdgcn_readfirstlane((int)(threadIdx.x >> 6));
    if (threadIdx.x < 2) ((volatile LAS unsigned*)(ldsl + 133120))[threadIdx.x] = 0u;
    __syncthreads();
    if (threadIdx.x == 0) (void)xb_add((unsigned*)Aarg.ws + XB_XCNT(xb_xcc_id()), 1u);
    for (int ph = ph_lo; ph < ph_hi; ++ph) {
        int bid = blockIdx.x; asm volatile("" : "+s"(bid));
        AP A = (AP)__builtin_amdgcn_kernarg_segment_ptr(); asm volatile("" : "+s"(A));
        int flag; const int k = step_k(ph % PH_PER_LAYER, flag);
        { const bool nosync = (ph != PH_TOTAL - 1) && (k_nosync(k) || (k == 0 && ph >= PH_PER_LAYER));
#ifdef EXTRA_BAR
          for (int xb = 0; xb < ((ph > ph_lo && !nosync) ? 1 + EXTRA_BAR : 0); ++xb) {
#else
          if (ph > ph_lo && !nosync) {
#endif
              xcd_barrier((unsigned*)A->ws, (volatile LAS unsigned*)(ldsl + 133120), mk_tid(wid0) == 0, (unsigned)G); } }
        unsigned char* ws = A->ws; float* out = A->out;
        bf16_t* H = (bf16_t*)(ws + WS_H); bf16_t* P = (bf16_t*)(ws + WS_P);
        const int l = ph / PH_PER_LAYER;
        if (ph == PH_TOTAL - 1) { const int tid = mk_tid(wid0); const int lane = tid & 63, gw = bid * 8 + (tid >> 6);
            const f32x4* gr = (const f32x4*)A->in[23] + lane;
            for (int m0 = gw * 2; m0 < MTOK; m0 += G * 16) {
                u32x2 w[2][4]; float sq[2];
#pragma unroll
                for (int i = 0; i < 2; ++i) { const u32x2* xr = (const u32x2*)(H + (size_t)(m0 + i) * DM) + lane;
#pragma unroll
                    for (int j = 0; j < 4; ++j) w[i][j] = xr[64 * j]; }
#pragma unroll
                for (int i = 0; i < 2; ++i) { float s = 0.f;
#pragma unroll
                    for (int j = 0; j < 4; ++j) { const float a = bf2f(w[i][j].x & 0xffffu), b = bf2f(w[i][j].x >> 16), c = bf2f(w[i][j].y & 0xffffu), d = bf2f(w[i][j].y >> 16); s += (a * a + b * b) + (c * c + d * d); }
                    sq[i] = rsqrtf(wave_sum(s) * (1.f / DM) + EPS); }
#pragma unroll
                for (int i = 0; i < 2; ++i) { f32x4* xr = (f32x4*)(out + (size_t)(m0 + i) * DM) + lane;
#pragma unroll
                    for (int j = 0; j < 4; ++j) { const f32x4 g4 = gr[64 * j]; f32x4 o; o.x = bf2f(w[i][j].x & 0xffffu) * sq[i] * g4.x; o.y = bf2f(w[i][j].x >> 16) * sq[i] * g4.y; o.z = bf2f(w[i][j].y & 0xffffu) * sq[i] * g4.z; o.w = bf2f(w[i][j].y >> 16) * sq[i] * g4.w; xr[64 * j] = o; } } }
            continue; }
        const float* xin = (l == 0) ? A->in[0] : out;
        unsigned char* wbl = (l == 0) ? ws : (unsigned char*)out + (size_t)(l - 1) * 37 * MiB - 1 * MiB;
        pg8::StaticOrder S;
#ifdef DUP_K
        for (int rep = 0; rep < ((k == DUP_K || k == DUP_K2) ? 2 : 1); ++rep)
#endif
        switch (k) {
        case 0: if (l == 0) {
                for (int ll = 0; ll < DEPTH; ++ll) phase_weights(wid0, bid, A, ll, (ll == 0) ? ws : (unsigned char*)out + (size_t)(ll - 1) * 37 * MiB - 1 * MiB, lds, G);
                phase_xcast(wid0, bid, xin, H, (float*)(ws + WS_SSQA), G); }
            break;
        case 1: { pg8::Gemm g{H, (const bf16_t*)(wbl + WS_WIN), MTOK, 4096, DM, DM}; S.init(MTOK, 4096, G, bid);
            pg8::EpiBf16<0, 0> E{P, LDP, nullptr, 0, (const float*)(ws + WS_SSQA)}; pg8::gemm_phase(wid0, ldsl, g, S, E); } break;
        case 2: if (!flag) phase_elem(wid0, bid, P, A->in[6] + l * 384, A->in[7] + l * 256, (const float*)(ws + WS_ROPE), (bf16_t*)(ws + WS_KRP), G);
            hgrn_pass1(wid0, bid, lds, P, (const float*)(ws + WS_LBS) + l * 512, (bf16_t*)(ws + WS_HST), (float*)(ws + WS_HGD), G);
            mamba_pass1(wid0, bid, lds, P, A->in[10] + l * 4 * 768, A->in[11] + l * 768, A->in[12] + l * 8, A->in[13] + l * 8, (bf16_t*)(ws + WS_MST), (float*)(ws + WS_MAT), G); break;
        case 3: hgrn_scan(wid0, bid, (bf16_t*)(ws + WS_HST), (const float*)(ws + WS_HGD), G); mamba_scan(wid0, bid, (bf16_t*)(ws + WS_MST), (const float*)(ws + WS_MAT), G); break;
        case 4: hgrn_pass3(wid0, bid, lds, flag ? (bf16_t*)(ws + WS_VT) : P + C_YA, flag ? 512 : LDP, P, (const float*)(ws + WS_LBS) + l * 512, A->in[5] + l * 512, (const bf16_t*)(ws + WS_HST), G); break;
        case 5: mamba_pass3(wid0, bid, lds, flag ? (bf16_t*)(ws + WS_VT) : P + C_YC, flag ? 512 : LDP, P, A->in[10] + l * 4 * 768, A->in[11] + l * 768, A->in[12] + l * 8, A->in[13] + l * 8, A->in[14] + l * 8, A->in[15] + l * 512, (const bf16_t*)(ws + WS_MST), G); break;
        case 6: { pg8::Gemm g{P + C_CQ, (const bf16_t*)(wbl + WS_WUQ), MTOK, 768, 384, LDP}; S.init(MTOK, 768, G, bid);
                    pg8::EpiQ E{(bf16_t*)(ws + WS_Q), (const float*)(ws + WS_ROPE)}; pg8::gemm_phase(wid0, ldsl, g, S, E); } break;
        case 7: { pg8::Gemm g{P + C_CKV, (const bf16_t*)(wbl + WS_WUK), MTOK, 512, 256, LDP}; S.init(MTOK, 512, G, bid);
                    pg8::EpiBf16<0, 0> E{(bf16_t*)(ws + WS_KN), 512, nullptr, 0, nullptr}; pg8::gemm_phase(wid0, ldsl, g, S, E); } break;
        case 8: { pg8::Gemm g{P + C_CKV, (const bf16_t*)(wbl + WS_WUV), MTOK, 512, 256, LDP}; S.init(MTOK, 512, G, bid);
                    pg8::EpiVT E{(bf16_t*)(ws + WS_VT)}; pg8::gemm_phase(wid0, ldsl, g, S, E); } break;
        case 9: phase_attn(wid0, bid, lds, (const bf16_t*)(ws + WS_Q), (const bf16_t*)(ws + WS_KN), (const bf16_t*)(ws + WS_KRP), (const bf16_t*)(ws + WS_VT), P, G); break;
        case 10: { S.init(MTOK, DM, G, bid);
            pg8::MergeArgs ma{H, P, (const bf16_t*)(wbl + WS_WIN) + (size_t)4096 * DM, (const bf16_t*)(wbl + WS_WBR)};
            pg8::EpiBf16<2, 0> EG{(bf16_t*)(ws + WS_G), DM, nullptr, 0, (const float*)(ws + WS_SSQA)};
            pg8::EpiBf16<0, 1> EB1{(bf16_t*)(ws + WS_MG), DM, (const bf16_t*)(ws + WS_G), DM, nullptr};
            pg8::EpiBf16<0, 2> EB2{(bf16_t*)(ws + WS_MG), DM, (const bf16_t*)(ws + WS_G), DM, nullptr};
            pg8::gemm_merge(wid0, ldsl, ma, S, EG, EB1, EB2); } break;
        case 11: case 12: case 13: case 14: case 15: break;
        case 16: { pg8::Gemm g{(const bf16_t*)(ws + WS_MG), (const bf16_t*)(wbl + WS_WOUT), MTOK, DM, DM, DM}; S.init(MTOK, DM, G, bid);
            pg8::EpiRes E{H, (float*)(ws + WS_SSQB)}; pg8::gemm_phase(wid0, ldsl, g, S, E); } break;
        case 17: break;
        case 18: { pg8::Gemm g{H, (const bf16_t*)(wbl + WS_WUP), MTOK, DFF, DM, DM}; S.init(MTOK, DFF, G, bid);
            pg8::EpiBf16<1, 0> E{P, DFF, nullptr, 0, (const float*)(ws + WS_SSQB)}; pg8::gemm_phase(wid0, ldsl, g, S, E); } break;
        case 19: { pg8::Gemm g{P, (const bf16_t*)(wbl + WS_WDN), MTOK, DM, DFF, DFF}; S.init(MTOK, DM, G, bid);
            pg8::EpiRes E{H, (float*)(ws + WS_SSQA)}; pg8::gemm_phase(wid0, ldsl, g, S, E); } break;
        }
    }
}

#ifdef DBG_STOP
__global__ void dbg_dump(const unsigned char* ws, float* out) {
    const bf16_t* B0 = (const bf16_t*)(ws + DBG_B0); const bf16_t* B1 = (const bf16_t*)(ws + DBG_B1);
    for (size_t e = (size_t)blockIdx.x * 256 + threadIdx.x; e < (size_t)MTOK * DM; e += (size_t)gridDim.x * 256) { const size_t m = e >> 10; const int c = (int)(e & 1023);
        out[e] = c < 512 ? bf2f(B0[m * DBG_P0 + c]) : bf2f(B1[m * DBG_P1 + (c - 512)]); }
}
#endif
extern "C" void kernel_launch(void* const* d_in, const int* in_sizes, int n_in, void* d_out, int out_size, void* d_ws, size_t ws_size, hipStream_t stream) {
    static int grid = 0;
    if (grid == 0) {
        if (n_in != 24 || out_size != MTOK * DM || ws_size < WS_END) { fprintf(stderr, "kernel_launch: unexpected shapes (n_in %d out %d ws %zu)\n", n_in, out_size, ws_size); grid = -1; return; }
        int dev = 0, cus = 0, per_cu = 0;
        hipGetDevice(&dev); hipDeviceGetAttribute(&cus, hipDeviceAttributeMultiprocessorCount, dev);
        hipFuncSetAttribute((const void*)fwd_mega, hipFuncAttributeMaxDynamicSharedMemorySize, LDS_BYTES);
        hipOccupancyMaxActiveBlocksPerMultiprocessor(&per_cu, (const void*)fwd_mega, 512, LDS_BYTES);
        (void)hipGetLastError();
        grid = (per_cu >= 1) ? cus : -1;
        if (grid < 0) { fprintf(stderr, "kernel_launch: occupancy query says 0 blocks/CU\n"); return; }
    }
    if (grid < 0) return;
    if (hipMemsetAsync(d_ws, 0, 16384, stream) != hipSuccess) { fprintf(stderr, "memset failed\n"); return; }
    Args a{};
    for (int i = 0; i < 24; ++i) a.in[i] = (const float*)d_in[i];
    a.out = (float*)d_out; a.ws = (unsigned char*)d_ws; a.ph_lo = 0; a.ph_hi = PH_TOTAL;
#ifndef MULTI_LAUNCH
#define MULTI_LAUNCH 0
#endif
#if MULTI_LAUNCH
#ifdef DBG_STOP
    const int PH_END = DBG_STOP;
#else
    const int PH_END = PH_TOTAL;
#endif
    for (int lo = 0; lo < PH_END; ) {
        int hi = lo + 1;

        while (hi < PH_TOTAL - 1) { int fl; if (k_nosync(step_k(hi % PH_PER_LAYER, fl))) ++hi; else break; }
        a.ph_lo = lo; a.ph_hi = hi;
        hipLaunchKernelGGL(fwd_mega, dim3(grid), dim3(512), LDS_BYTES, stream, a);
        lo = hi;
    }
#ifdef DBG_STOP
    hipLaunchKernelGGL(dbg_dump, dim3(2048), dim3(256), 0, stream, (const unsigned char*)d_ws, (float*)d_out);
#endif
#else
    void* args[] = {&a};
    hipError_t e = hipLaunchCooperativeKernel((const void*)fwd_mega, dim3(grid), dim3(512), args, LDS_BYTES, stream);
    if (e != hipSuccess) fprintf(stderr, "cooperative launch failed: %s (grid %d)\n", hipGetErrorString(e), grid);
#endif
}
```

```cpp
#include <hip/hip_runtime.h>
#include <hip/hip_cooperative_groups.h>
#include <cstdio>
#include <cstdint>
namespace cg = cooperative_groups;

typedef unsigned short bf16_t;
typedef short bf16x8 __attribute__((ext_vector_type(8)));
typedef short s16x4 __attribute__((ext_vector_type(4)));
typedef float f32x4 __attribute__((ext_vector_type(4)));
typedef float f32x16 __attribute__((ext_vector_type(16)));
typedef unsigned u32x4 __attribute__((ext_vector_type(4)));
typedef unsigned u32x2 __attribute__((ext_vector_type(2)));
#define LAS __attribute__((address_space(3)))

constexpr int DM = 1024, NB = 8, SEQ = 4096, DEPTH = 4, MTOK = NB * SEQ;
constexpr int LDP = 4096;
constexpr int C_HQ = 0, C_HF = 512, C_HI = 1024, C_HG = 1536, C_CQ = 2048, C_CKV = 2432, C_KR = 2688, C_SZ = 2720, C_XBC = 3232, C_DT = 4000;
constexpr int C_YA = C_HQ, C_YB = C_CQ, C_YC = C_SZ;
constexpr int IN_COLS = 7080, NPROJ = 4008, DFF = 4096;
constexpr float EPS = 1e-6f;
constexpr float QSCALE = 0.10206207261596575f * 1.4426950408889634f;

constexpr size_t MiB = 1u << 20;
constexpr size_t WS_WIN = 1 * MiB;
constexpr size_t WS_WUQ = 15 * MiB;
constexpr size_t WS_WUK = 16 * MiB;
constexpr size_t WS_WUV = WS_WUK + 512 * 256 * 2;
constexpr size_t WS_WBR = 17 * MiB;
constexpr size_t WS_WOUT = 20 * MiB;
constexpr size_t WS_WUP = 22 * MiB;
constexpr size_t WS_WDN = 30 * MiB;
constexpr size_t WS_ROPE = 38 * MiB;
constexpr size_t WS_LBS = 42 * MiB;
constexpr size_t WS_HGD = 42 * MiB + 65536;
constexpr size_t WS_MAT = 43 * MiB + 131072;
constexpr size_t WS_SSQA = 492 * MiB;
constexpr size_t WS_SSQB = 494 * MiB;
constexpr size_t WS_H = 44 * MiB;
constexpr size_t WS_P = 108 * MiB;
constexpr size_t WS_R = 364 * MiB;
constexpr size_t WS_HST = WS_R;
constexpr size_t WS_MST = WS_R + 64 * MiB;
constexpr size_t WS_Q = WS_R;
constexpr size_t WS_KN = WS_R + 48 * MiB;
constexpr size_t WS_VT = WS_R + 80 * MiB;
constexpr size_t WS_KRP = WS_R + 112 * MiB;
constexpr size_t WS_G = WS_R;
constexpr size_t WS_MG = WS_R + 64 * MiB;
constexpr size_t WS_END = 496 * MiB;

__device__ __forceinline__ float bf2f(unsigned v) { return __uint_as_float(v << 16); }
__device__ __forceinline__ unsigned f2bf(float f) { unsigned u = __float_as_uint(f); return (u + 0x7fffu + ((u >> 16) & 1u)) >> 16; }
__device__ __forceinline__ unsigned pk2(float lo, float hi) { return f2bf(lo) | (f2bf(hi) << 16); }
typedef float f32x2_t __attribute__((ext_vector_type(2))); typedef __bf16 bf16x2_t __attribute__((ext_vector_type(2)));
__device__ __forceinline__ unsigned cvt_pk_bf16(float lo, float hi) { f32x2_t v = {lo, hi}; bf16x2_t b = __builtin_convertvector(v, bf16x2_t); return __builtin_bit_cast(unsigned, b); }
__device__ __forceinline__ float sigmoidf_(float x) { return __builtin_amdgcn_rcpf(1.f + __expf(-x)); }
__device__ __forceinline__ float siluf_(float x) { return x * sigmoidf_(x); }
__device__ __forceinline__ int crow(int r, int h) { return (r & 3) + 8 * (r >> 2) + 4 * h; }
__device__ __forceinline__ float wave_sum(float v) {
#pragma unroll
    for (int o = 1; o < 64; o <<= 1) v += __shfl_xor(v, o);
    return v;
}
__device__ __forceinline__ int mk_tid(int wid0) { int l; asm volatile("v_mbcnt_lo_u32_b32 %0, -1, 0\n\tv_mbcnt_hi_u32_b32 %0, -1, %0" : "=v"(l)); return l + wid0 * 64; }
#define MFMA32(a, b, c) __builtin_amdgcn_mfma_f32_32x32x16_bf16((a), (b), (c), 0, 0, 0)
__device__ __forceinline__ bf16x8 pack8(const f32x16& c, int s) {
    u32x4 w; w.x = cvt_pk_bf16(c[8 * s + 0], c[8 * s + 1]); w.y = cvt_pk_bf16(c[8 * s + 2], c[8 * s + 3]);
    w.z = cvt_pk_bf16(c[8 * s + 4], c[8 * s + 5]); w.w = cvt_pk_bf16(c[8 * s + 6], c[8 * s + 7]); return __builtin_bit_cast(bf16x8, w);
}
__device__ __forceinline__ bf16x8 ld2x64(const unsigned char* p0, const unsigned char* p1) {
    const u32x2 a = *(const u32x2*)p0, b = *(const u32x2*)p1; u32x4 w; w.x = a.x; w.y = a.y; w.z = b.x; w.w = b.y; return __builtin_bit_cast(bf16x8, w);
}

namespace pg8 {
constexpr int BM = 256, BK = 64, HALF = 128, HTB = HALF * BK * 2, STAGE_BYTES = 8 * HTB, NXCD = 8, WGM = 8;
__host__ __device__ __forceinline__ int lds_byte(int r, int c) { const int st = (r >> 4) * 2 + (c >> 5), rr = r & 15, cc = c & 31, ob = rr * 64 + cc * 2; return st * 1024 + (ob ^ (((ob >> 9) & 1) << 5)); }
__host__ __device__ __forceinline__ void stage_rc(int b, int& R, int& C) { const int st = b / 1024, sb = b % 1024, swz = sb ^ (((sb >> 9) & 1) << 5); R = (st >> 1) * 16 + swz / 64; C = (st & 1) * 32 + (swz % 64) / 2; }
__host__ __device__ __forceinline__ int perm32(int rho) { const int n = rho >> 4, i = rho & 15; return 8 * (i >> 2) + 4 * n + (i & 3); }
struct Unit { int pm, pn; };
struct Gemm { const bf16_t* A; const bf16_t* Bt; int M, N, K, lda; };
struct StaticOrder {
    int nM, nN, nwg, G, c;
    __device__ void init(int M, int N, int G_, int c_) { nM = M / BM; nN = N / BM; nwg = nM * nN; G = G_; c = c_; }
    __device__ bool next(int i, Unit& u) const {
        const long L = (long)i * G + c; if (L >= nwg) return false;
        int wgid = (int)L; { const int q = nwg / NXCD, r = nwg % NXCD, xcd = wgid % NXCD, off = wgid / NXCD; wgid = (xcd < r ? xcd * (q + 1) : r * (q + 1) + (xcd - r) * q) + off; }
        const int nig = WGM * nN, gid = wgid / nig, fm = gid * WGM, gsz = (nM - fm) < WGM ? (nM - fm) : WGM;
        u.pm = fm + ((wgid % nig) % gsz); u.pn = (wgid % nig) / gsz; return true;
    }
};
template <class Epi>
__device__ __forceinline__ void gemm_phase(int wid0, LAS unsigned char* lds, const Gemm g, const StaticOrder& S, const Epi& E) {
    const int tid = mk_tid(wid0);
    const int wid = __builtin_amdgcn_readfirstlane(tid >> 6), lane = tid & 63, wr = wid >> 2, wc = wid & 3, fr = lane & 15, fq = lane >> 4;
    int K = g.K; asm volatile("" : "+s"(K));
    const int nt = K / BK, lda = g.lda;
    unsigned voffA_, voffB_;
    { int R, C; stage_rc(tid * 16, R, C); const int Rb = Epi::PERM ? ((R & ~31) + perm32(R & 31)) : R;
      voffA_ = (unsigned)(R * lda + C) * 2u; voffB_ = (unsigned)(Rb * K + C) * 2u; }
    const unsigned voA = voffA_, voB = voffB_;
    const unsigned v2A = 64u * (unsigned)lda * 2u, v2B = 64u * (unsigned)K * 2u;
    const size_t kstep = (size_t)(BK * 2);
    const size_t hstepA = (size_t)HALF * lda * 2, tstepA = 2 * hstepA;
    const size_t hstepB = (size_t)HALF * K * 2, tstepB = 2 * hstepB;
    const unsigned ldsw = (unsigned)wid * 1024u;
    const int aoff = lds_byte(wr * 64 + fr, fq * 8), boff = lds_byte(wc * 32 + fr, fq * 8);
#define PG8_SA(b, h) (((b) * 2 + (h)) * HTB)
#define PG8_SB(b, h) ((4 + (b) * 2 + (h)) * HTB)
#define PG8_STAGE(bufoff, gbase, voff) do { _Pragma("unroll") for (int _i = 0; _i < 2; ++_i) \
        __builtin_amdgcn_global_load_lds((const unsigned*)((const char*)(gbase) + (size_t)(_i * v2##voff) + vo##voff), (LAS unsigned*)(lds + (bufoff) + ldsw + _i * 8192), 16, 0, 0); } while (0)
#define PG8_LDA(dst, b, h) do { _Pragma("unroll") for (int m = 0; m < 4; ++m) _Pragma("unroll") for (int k = 0; k < 2; ++k) dst[m][k] = *(const LAS bf16x8*)(lds + PG8_SA(b, h) + aoff + m * 2048 + k * 1024); } while (0)
#define PG8_LDB(dst, b, h) do { _Pragma("unroll") for (int n = 0; n < 2; ++n) _Pragma("unroll") for (int k = 0; k < 2; ++k) dst[n][k] = *(const LAS bf16x8*)(lds + PG8_SB(b, h) + boff + n * 2048 + k * 1024); } while (0)
#define PG8_MMA(ai, bj, At, Bt) do { __builtin_amdgcn_s_setprio(1); _Pragma("unroll") for (int m = 0; m < 4; ++m) _Pragma("unroll") for (int n = 0; n < 2; ++n) _Pragma("unroll") for (int k = 0; k < 2; ++k) \
        acc[ai][bj][m][n] = Epi::SWAP ? __builtin_amdgcn_mfma_f32_16x16x32_bf16(Bt[n][k], At[m][k], acc[ai][bj][m][n], 0, 0, 0) \
                                      : __builtin_amdgcn_mfma_f32_16x16x32_bf16(At[m][k], Bt[n][k], acc[ai][bj][m][n], 0, 0, 0); __builtin_amdgcn_s_setprio(0); } while (0)
#define PG8_WAIT_V(n) asm volatile("s_waitcnt vmcnt(" #n ")" ::: "memory")
#define PG8_WAIT_L(n) asm volatile("s_waitcnt lgkmcnt(" #n ")" ::: "memory")
#define PG8_BAR __builtin_amdgcn_s_barrier()
#define PG8_SCHED __builtin_amdgcn_sched_barrier(0)
    Unit cur, nxt; int ui = 0;
    if (!S.next(0, cur)) return;
    f32x4 acc[2][2][4][2];
#pragma unroll
    for (int a = 0; a < 2; ++a)
#pragma unroll
        for (int b = 0; b < 2; ++b)
#pragma unroll
            for (int m = 0; m < 4; ++m)
#pragma unroll
                for (int n = 0; n < 2; ++n) acc[a][b][m][n] = (f32x4){0.f, 0.f, 0.f, 0.f};
    bf16x8 At[4][2], B0[2][2], B1[2][2];
    const char* cA = (const char*)g.A + (size_t)cur.pm * tstepA; const char* cB = (const char*)g.Bt + (size_t)cur.pn * tstepB;
    LAS float* const tab0 = (LAS float*)(lds + STAGE_BYTES);
    if constexpr (Epi::HAS_PRE) E.pre(tab0, cur, tid);
    PG8_STAGE(PG8_SB(0, 0), cB, B); PG8_STAGE(PG8_SB(0, 1), cB + hstepB, B); PG8_STAGE(PG8_SA(0, 0), cA, A); PG8_STAGE(PG8_SA(0, 1), cA + hstepA, A);
    if (wr == 1) PG8_BAR;
    PG8_WAIT_V(2); PG8_BAR;
    PG8_STAGE(PG8_SB(1, 0), cB + kstep, B); PG8_STAGE(PG8_SA(1, 0), cA + kstep, A); PG8_STAGE(PG8_SB(1, 1), cB + hstepB + kstep, B);
    PG8_WAIT_V(6); PG8_BAR;
    for (;;) {
        const bool has_next = S.next(ui + 1, nxt);
        const char* nA = has_next ? (const char*)g.A + (size_t)nxt.pm * tstepA : cA; const char* nB = has_next ? (const char*)g.Bt + (size_t)nxt.pn * tstepB : cB;
        for (int t = 0; t < nt; t += 2) {
            const bool last = (t == nt - 2);
            const char* a1 = cA + (size_t)(t + 1) * kstep;
            const char* a2 = last ? nA : cA + (size_t)(t + 2) * kstep; const char* b2 = last ? nB : cB + (size_t)(t + 2) * kstep;
            const char* a3 = a2 + kstep; const char* b3 = b2 + kstep;
            PG8_LDB(B0, 0, 0); PG8_LDB(B1, 0, 1); PG8_SCHED; PG8_LDA(At, 0, 0); PG8_STAGE(PG8_SA(1, 1), a1 + hstepA, A);
            PG8_WAIT_V(8); PG8_WAIT_L(0); PG8_BAR; PG8_MMA(0, 0, At, B0); PG8_MMA(0, 1, At, B1); PG8_BAR; PG8_SCHED;
            PG8_LDA(At, 0, 1); PG8_STAGE(PG8_SB(0, 0), b2, B); PG8_STAGE(PG8_SB(0, 1), b2 + hstepB, B); PG8_STAGE(PG8_SA(0, 0), a2, A);
            PG8_WAIT_V(8); PG8_WAIT_L(0); PG8_BAR; PG8_MMA(1, 0, At, B0); PG8_MMA(1, 1, At, B1); PG8_BAR; PG8_SCHED;
            PG8_LDB(B0, 1, 0); PG8_LDB(B1, 1, 1); PG8_SCHED; PG8_LDA(At, 1, 0); PG8_STAGE(PG8_SA(0, 1), a2 + hstepA, A);
            PG8_WAIT_V(8); PG8_WAIT_L(0); PG8_BAR; PG8_MMA(0, 0, At, B0); PG8_MMA(0, 1, At, B1); PG8_BAR; PG8_SCHED;
            PG8_LDA(At, 1, 1); PG8_STAGE(PG8_SB(1, 0), b3, B); PG8_STAGE(PG8_SB(1, 1), b3 + hstepB, B); PG8_STAGE(PG8_SA(1, 0), a3, A);
            PG8_WAIT_V(8); PG8_WAIT_L(0); PG8_BAR; PG8_MMA(1, 0, At, B0); PG8_MMA(1, 1, At, B1); PG8_BAR; PG8_SCHED;
        }
        if (wr == 0) PG8_BAR;
        { int le; asm volatile("v_mbcnt_lo_u32_b32 %0, -1, 0\n\tv_mbcnt_hi_u32_b32 %0, -1, %0" : "=v"(le));
          E(acc, cur, wr, wc, le & 15, le >> 4, tab0 + (ui & 1) * 256); }
        if (!has_next) break;
#pragma unroll
        for (int a = 0; a < 2; ++a)
#pragma unroll
            for (int b = 0; b < 2; ++b)
#pragma unroll
                for (int m = 0; m < 4; ++m)
#pragma unroll
                    for (int n = 0; n < 2; ++n) acc[a][b][m][n] = (f32x4){0.f, 0.f, 0.f, 0.f};
        cur = nxt; cA = nA; cB = nB; ++ui;
        if constexpr (Epi::HAS_PRE) E.pre(tab0 + (ui & 1) * 256, cur, mk_tid(wid0));
        if (wr == 1) PG8_BAR;
    }
    PG8_WAIT_V(0);
    PG8_BAR;
#undef PG8_SA
#undef PG8_SB
#undef PG8_STAGE
#undef PG8_LDA
#undef PG8_LDB
#undef PG8_MMA
#undef PG8_WAIT_V
#undef PG8_WAIT_L
#undef PG8_BAR
#undef PG8_SCHED
}

template <int ACT, int MODE> struct EpiBf16 {
    static constexpr bool PERM = true, SWAP = true, HAS_PRE = true;
    bf16_t* O; int ldc; const bf16_t* Gt; int ldg; const float* ssq;
    __device__ __forceinline__ void pre(LAS float* tab, const Unit& u, int tid) const {
        if (ssq && tid < 256) { const f32x4* sp = (const f32x4*)(ssq + (size_t)(u.pm * BM + tid) * 16); const f32x4 s0 = sp[0], s1 = sp[1], s2 = sp[2], s3 = sp[3];
            tab[tid] = rsqrtf(((((s0[0] + s0[1]) + (s0[2] + s0[3])) + ((s1[0] + s1[1]) + (s1[2] + s1[3]))) + (((s2[0] + s2[1]) + (s2[2] + s2[3])) + ((s3[0] + s3[1]) + (s3[2] + s3[3])))) * (1.f / DM) + EPS); }
    }
    __device__ __forceinline__ void operator()(const f32x4 (&acc)[2][2][4][2], const Unit& u, int wr, int wc, int fr, int fq, const LAS float* tab) const {
        const int row0 = u.pm * BM + wr * 64 + fr, col0 = u.pn * BM + wc * 32 + 8 * fq;
#pragma unroll
        for (int ai = 0; ai < 2; ++ai)
#pragma unroll
            for (int m = 0; m < 4; ++m) { const size_t r = (size_t)(row0 + ai * HALF + m * 16); bf16_t* rowp = O + r * ldc + col0; const float rs = ssq ? tab[ai * HALF + wr * 64 + m * 16 + fr] : 1.f;
#pragma unroll
                for (int bj = 0; bj < 2; ++bj) { f32x4 v0 = acc[ai][bj][m][0], v1 = acc[ai][bj][m][1];
                    float v[8] = {v0[0] * rs, v0[1] * rs, v0[2] * rs, v0[3] * rs, v1[0] * rs, v1[1] * rs, v1[2] * rs, v1[3] * rs};
                    if (ACT == 1) {
#pragma unroll
                        for (int e = 0; e < 8; ++e) { const float t = v[e] > 0.f ? v[e] : 0.f; v[e] = t * t; } }
                    if (ACT == 2) {
#pragma unroll
                        for (int e = 0; e < 8; ++e) v[e] = sigmoidf_(v[e]); }
                    if (MODE >= 1) { const u32x4 gw = *(const u32x4*)(Gt + r * ldg + col0 + bj * HALF);
                        const unsigned gg[4] = {gw.x, gw.y, gw.z, gw.w};
#pragma unroll
                        for (int e = 0; e < 4; ++e) { v[2 * e] *= bf2f(gg[e] & 0xffffu); v[2 * e + 1] *= bf2f(gg[e] >> 16); } }
                    if (MODE == 2) { const u32x4 ow = *(const u32x4*)(rowp + bj * HALF);
                        const unsigned oo[4] = {ow.x, ow.y, ow.z, ow.w};
#pragma unroll
                        for (int e = 0; e < 4; ++e) { v[2 * e] += bf2f(oo[e] & 0xffffu); v[2 * e + 1] += bf2f(oo[e] >> 16); } }
                    u32x4 w; w.x = cvt_pk_bf16(v[0], v[1]); w.y = cvt_pk_bf16(v[2], v[3]); w.z = cvt_pk_bf16(v[4], v[5]); w.w = cvt_pk_bf16(v[6], v[7]);
                    *(u32x4*)(rowp + bj * HALF) = w; } }
    }
};
struct EpiRes {
    static constexpr bool PERM = false, SWAP = true, HAS_PRE = false;
    bf16_t* xb; float* ssq;
    __device__ __forceinline__ void operator()(const f32x4 (&acc)[2][2][4][2], const Unit& u, int wr, int wc, int fr, int fq, const LAS float* tab) const {
        const int col0 = u.pn * BM + wc * 32 + 4 * fq; const int r0 = u.pm * BM + wr * 64 + fr;
        bf16_t* xp = xb + (size_t)r0 * DM + col0;
#pragma unroll
        for (int ai = 0; ai < 2; ++ai) {
            u32x2 bs[4][2][2];
#pragma unroll
            for (int m = 0; m < 4; ++m)
#pragma unroll
                for (int bj = 0; bj < 2; ++bj)
#pragma unroll
                    for (int n = 0; n < 2; ++n) bs[m][bj][n] = *(const u32x2*)(xp + (size_t)(ai * HALF + m * 16) * DM + bj * HALF + n * 16);
            asm volatile("" ::: "memory");
#pragma unroll
            for (int m = 0; m < 4; ++m) { float sq = 0.f;
#pragma unroll
                for (int bj = 0; bj < 2; ++bj)
#pragma unroll
                    for (int n = 0; n < 2; ++n) { const u32x2 bw = bs[m][bj][n]; const f32x4 a = acc[ai][bj][m][n];
                        const float v0 = bf2f(bw.x & 0xffffu) + a[0], v1 = bf2f(bw.x >> 16) + a[1], v2 = bf2f(bw.y & 0xffffu) + a[2], v3 = bf2f(bw.y >> 16) + a[3];
                        sq += (v0 * v0 + v1 * v1) + (v2 * v2 + v3 * v3);
                        u32x2 w; w.x = cvt_pk_bf16(v0, v1); w.y = cvt_pk_bf16(v2, v3); *(u32x2*)(xp + (size_t)(ai * HALF + m * 16) * DM + bj * HALF + n * 16) = w; }
                sq += __shfl_xor(sq, 16); sq += __shfl_xor(sq, 32);
                if (fq == 0) ssq[(size_t)(r0 + ai * HALF + m * 16) * 16 + u.pn * 4 + wc] = sq; }
            asm volatile("" ::: "memory"); }
    }
};
struct EpiQ {
    static constexpr bool PERM = false, SWAP = true, HAS_PRE = false;
    bf16_t* O; const float* rope;
    __device__ __forceinline__ void operator()(const f32x4 (&acc)[2][2][4][2], const Unit& u, int wr, int wc, int fr, int fq, const LAS float* tab) const {
        const int r0 = u.pm * BM + wr * 64 + fr, g0 = u.pn * 8 + wc;
        bf16_t* ob = O + (size_t)r0 * 768 + g0 * 32 + 4 * fq; const float* rb = rope + (size_t)r0 * 32 + 4 * fq;
#pragma unroll
        for (int bj = 0; bj < 2; ++bj) { const bool isrope = ((g0 + 4 * bj) % 3) == 2;
#pragma unroll
            for (int ai = 0; ai < 2; ++ai)
#pragma unroll
                for (int m = 0; m < 4; ++m) { const int ro = ai * HALF + m * 16;
                    f32x4 x1 = acc[ai][bj][m][0], x2 = acc[ai][bj][m][1];
                    if (isrope) { const f32x4 c = *(const f32x4*)(rb + ro * 32), s = *(const f32x4*)(rb + ro * 32 + 16);
                        const f32x4 y1 = x1 * c - x2 * s, y2 = x2 * c + x1 * s; x1 = y1; x2 = y2; }
                    x1 = x1 * QSCALE; x2 = x2 * QSCALE;
                    u32x2 w1, w2; w1.x = cvt_pk_bf16(x1[0], x1[1]); w1.y = cvt_pk_bf16(x1[2], x1[3]); w2.x = cvt_pk_bf16(x2[0], x2[1]); w2.y = cvt_pk_bf16(x2[2], x2[3]);
                    *(u32x2*)(ob + ro * 768 + bj * 128) = w1; *(u32x2*)(ob + ro * 768 + bj * 128 + 16) = w2; asm volatile("" ::: "memory"); } }
    }
};
struct EpiVT {
    static constexpr bool PERM = false, SWAP = false, HAS_PRE = false;
    bf16_t* VT;
    __device__ __forceinline__ void operator()(const f32x4 (&acc)[2][2][4][2], const Unit& u, int wr, int wc, int fr, int fq, const LAS float* tab) const {
        const int c0 = u.pn * BM + wc * 32 + fr, r0 = u.pm * BM + wr * 64 + 4 * fq;
        bf16_t* base = VT + ((size_t)(((r0 >> 12) * 8 + (c0 >> 6)) * 64 + (c0 & 63))) * SEQ + (r0 & 4095);
#pragma unroll
        for (int bj = 0; bj < 2; ++bj)
#pragma unroll
            for (int n = 0; n < 2; ++n)
#pragma unroll
                for (int ai = 0; ai < 2; ++ai)
#pragma unroll
                    for (int m = 0; m < 4; ++m) { const f32x4 v = acc[ai][bj][m][n]; u32x2 w; w.x = cvt_pk_bf16(v[0], v[1]); w.y = cvt_pk_bf16(v[2], v[3]);
                        *(u32x2*)(base + (size_t)(bj * 128 + n * 16) * SEQ + ai * HALF + m * 16) = w; }
    }
};
struct MergeArgs { const bf16_t* H; const bf16_t* P; const bf16_t* Wg; const bf16_t* Wbr; };
template <class EpiG, class EpiB1, class EpiB2>
__device__ __forceinline__ void gemm_merge(int wid0, LAS unsigned char* lds, const MergeArgs ma, const StaticOrder& S, const EpiG& EG, const EpiB1& EB1, const EpiB2& EB2) {
    const int tid = mk_tid(wid0);
    const int wid = __builtin_amdgcn_readfirstlane(tid >> 6), lane = tid & 63, wr = wid >> 2, wc = wid & 3, fr = lane & 15, fq = lane >> 4;
    int KG = DM, KH = 512; asm volatile("" : "+s"(KG)); asm volatile("" : "+s"(KH));
    unsigned voA0, voA1, voB0, voB1;
    { int R, C; stage_rc(tid * 16, R, C); const int Rb = (R & ~31) + perm32(R & 31);
      voA0 = (unsigned)(R * DM + C) * 2u; voA1 = (unsigned)(R * LDP + C) * 2u; voB0 = (unsigned)(Rb * KG + C) * 2u; voB1 = (unsigned)(Rb * KH + C) * 2u; }
    const size_t kstep = (size_t)(BK * 2);
    const unsigned ldsw = (unsigned)wid * 1024u;
    const int aoff = lds_byte(wr * 64 + fr, fq * 8), boff = lds_byte(wc * 32 + fr, fq * 8);
#define PG8_SA(b, h) (((b) * 2 + (h)) * HTB)
#define PG8_SB(b, h) ((4 + (b) * 2 + (h)) * HTB)
#define PG8_STG(bufoff, gbase, vo, v2) do { _Pragma("unroll") for (int _i = 0; _i < 2; ++_i) \
        __builtin_amdgcn_global_load_lds((const unsigned*)((const char*)(gbase) + (size_t)(_i * (v2)) + (vo)), (LAS unsigned*)(lds + (bufoff) + ldsw + _i * 8192), 16, 0, 0); } while (0)
#define PG8_LDA(dst, b, h) do { _Pragma("unroll") for (int m = 0; m < 4; ++m) _Pragma("unroll") for (int k = 0; k < 2; ++k) dst[m][k] = *(const LAS bf16x8*)(lds + PG8_SA(b, h) + aoff + m * 2048 + k * 1024); } while (0)
#define PG8_LDB(dst, b, h) do { _Pragma("unroll") for (int n = 0; n < 2; ++n) _Pragma("unroll") for (int k = 0; k < 2; ++k) dst[n][k] = *(const LAS bf16x8*)(lds + PG8_SB(b, h) + boff + n * 2048 + k * 1024); } while (0)
#define PG8_MMA(ai, bj, At, Bt) do { __builtin_amdgcn_s_setprio(1); _Pragma("unroll") for (int m = 0; m < 4; ++m) _Pragma("unroll") for (int n = 0; n < 2; ++n) _Pragma("unroll") for (int k = 0; k < 2; ++k) \
        acc[ai][bj][m][n] = __builtin_amdgcn_mfma_f32_16x16x32_bf16(Bt[n][k], At[m][k], acc[ai][bj][m][n], 0, 0, 0); __builtin_amdgcn_s_setprio(0); } while (0)
#define PG8_WAIT_V(n) asm volatile("s_waitcnt vmcnt(" #n ")" ::: "memory")
#define PG8_WAIT_L(n) asm volatile("s_waitcnt lgkmcnt(" #n ")" ::: "memory")
#define PG8_BAR __builtin_amdgcn_s_barrier()
#define PG8_SCHED __builtin_amdgcn_sched_barrier(0)
#define MG_ITEM(it, U, KIND, PA, PB) do { const int j_ = (it) % 6, i_ = j_ >> 1; KIND = j_ & 1; \
        PA = KIND ? (const char*)(ma.P + (i_ == 0 ? C_YA : (i_ == 1 ? C_YB : C_YC)) + (size_t)U.pm * BM * LDP) : (const char*)(ma.H + (size_t)U.pm * BM * DM); \
        PB = KIND ? (const char*)(ma.Wbr + ((size_t)i_ * DM + (size_t)U.pn * BM) * 512) : (const char*)(ma.Wg + ((size_t)i_ * DM + (size_t)U.pn * BM) * DM); } while (0)
    Unit cur, nxt; int it = 0;
    if (!S.next(0, cur)) return;
    f32x4 acc[2][2][4][2];
#pragma unroll
    for (int a = 0; a < 2; ++a)
#pragma unroll
        for (int b = 0; b < 2; ++b)
#pragma unroll
            for (int m = 0; m < 4; ++m)
#pragma unroll
                for (int n = 0; n < 2; ++n) acc[a][b][m][n] = (f32x4){0.f, 0.f, 0.f, 0.f};
    bf16x8 At[4][2], B0[2][2], B1[2][2];
    int ck; const char* cA; const char* cB; MG_ITEM(0, cur, ck, cA, cB);
    LAS float* const tab0 = (LAS float*)(lds + STAGE_BYTES);
    EG.pre(tab0, cur, tid);
    { const unsigned voA = ck ? voA1 : voA0, voB = ck ? voB1 : voB0, v2A = 128u * (ck ? LDP : DM), v2B = 128u * (unsigned)(ck ? KH : KG); const size_t hA = 2 * (size_t)v2A, hB = 2 * (size_t)v2B;
      PG8_STG(PG8_SB(0, 0), cB, voB, v2B); PG8_STG(PG8_SB(0, 1), cB + hB, voB, v2B); PG8_STG(PG8_SA(0, 0), cA, voA, v2A); PG8_STG(PG8_SA(0, 1), cA + hA, voA, v2A);
      if (wr == 1) PG8_BAR;
      PG8_WAIT_V(2); PG8_BAR;
      PG8_STG(PG8_SB(1, 0), cB + kstep, voB, v2B); PG8_STG(PG8_SA(1, 0), cA + kstep, voA, v2A); PG8_STG(PG8_SB(1, 1), cB + hB + kstep, voB, v2B);
      PG8_WAIT_V(6); PG8_BAR; }
    for (;;) {
        const int j = it % 6;
        bool has_next; int nk; const char* nA; const char* nB;
        if (j < 5) { has_next = true; nxt = cur; } else { has_next = S.next(it / 6 + 1, nxt); }
        if (has_next) MG_ITEM(it + 1, nxt, nk, nA, nB); else { nk = ck; nA = cA; nB = cB; }
        const unsigned cvoA = ck ? voA1 : voA0, cvoB = ck ? voB1 : voB0, cv2A = 128u * (ck ? LDP : DM), cv2B = 128u * (unsigned)(ck ? KH : KG); const size_t chA = 2 * (size_t)cv2A, chB = 2 * (size_t)cv2B;
        const unsigned nvoA = nk ? voA1 : voA0, nvoB = nk ? voB1 : voB0, nv2A = 128u * (nk ? LDP : DM), nv2B = 128u * (unsigned)(nk ? KH : KG); const size_t nhA = 2 * (size_t)nv2A, nhB = 2 * (size_t)nv2B;
        const int nt = (ck ? KH : KG) / BK;
        for (int t = 0; t < nt; t += 2) {
            const bool last = (t == nt - 2);
            const char* a1 = cA + (size_t)(t + 1) * kstep;
            const char* a2 = last ? nA : cA + (size_t)(t + 2) * kstep; const char* b2 = last ? nB : cB + (size_t)(t + 2) * kstep;
            const char* a3 = a2 + kstep; const char* b3 = b2 + kstep;
            const unsigned xvoA = last ? nvoA : cvoA, xvoB = last ? nvoB : cvoB, xv2A = last ? nv2A : cv2A, xv2B = last ? nv2B : cv2B; const size_t xhA = last ? nhA : chA, xhB = last ? nhB : chB;
            PG8_LDB(B0, 0, 0); PG8_LDB(B1, 0, 1); PG8_SCHED; PG8_LDA(At, 0, 0); PG8_STG(PG8_SA(1, 1), a1 + chA, cvoA, cv2A);
            PG8_WAIT_V(8); PG8_WAIT_L(0); PG8_BAR; PG8_MMA(0, 0, At, B0); PG8_MMA(0, 1, At, B1); PG8_BAR; PG8_SCHED;
            PG8_LDA(At, 0, 1); PG8_STG(PG8_SB(0, 0), b2, xvoB, xv2B); PG8_STG(PG8_SB(0, 1), b2 + xhB, xvoB, xv2B); PG8_STG(PG8_SA(0, 0), a2, xvoA, xv2A);
            PG8_WAIT_V(8); PG8_WAIT_L(0); PG8_BAR; PG8_MMA(1, 0, At, B0); PG8_MMA(1, 1, At, B1); PG8_BAR; PG8_SCHED;
            PG8_LDB(B0, 1, 0); PG8_LDB(B1, 1, 1); PG8_SCHED; PG8_LDA(At, 1, 0); PG8_STG(PG8_SA(0, 1), a2 + xhA, xvoA, xv2A);
            PG8_WAIT_V(8); PG8_WAIT_L(0); PG8_BAR; PG8_MMA(0, 0, At, B0); PG8_MMA(0, 1, At, B1); PG8_BAR; PG8_SCHED;
            PG8_LDA(At, 1, 1); PG8_STG(PG8_SB(1, 0), b3, xvoB, xv2B); PG8_STG(PG8_SB(1, 1), b3 + xhB, xvoB, xv2B); PG8_STG(PG8_SA(1, 0), a3, xvoA, xv2A);
            PG8_WAIT_V(8); PG8_WAIT_L(0); PG8_BAR; PG8_MMA(1, 0, At, B0); PG8_MMA(1, 1, At, B1); PG8_BAR; PG8_SCHED;
        }
        if (wr == 0) PG8_BAR;
        { int le; asm volatile("v_mbcnt_lo_u32_b32 %0, -1, 0\n\tv_mbcnt_hi_u32_b32 %0, -1, %0" : "=v"(le));
          const LAS float* tb = tab0 + ((it / 6) & 1) * 256;
          if ((j & 1) == 0) EG(acc, cur, wr, wc, le & 15, le >> 4, tb); else if (j == 1) EB1(acc, cur, wr, wc, le & 15, le >> 4, tb); else EB2(acc, cur, wr, wc, le & 15, le >> 4, tb); }
        if (!has_next) break;
#pragma unroll
        for (int a = 0; a < 2; ++a)
#pragma unroll
            for (int b = 0; b < 2; ++b)
#pragma unroll
                for (int m = 0; m < 4; ++m)
#pragma unroll
                    for (int n = 0; n < 2; ++n) acc[a][b][m][n] = (f32x4){0.f, 0.f, 0.f, 0.f};
        ++it; ck = nk; cA = nA; cB = nB;
        if (j == 5) { cur = nxt; EG.pre(tab0 + ((it / 6) & 1) * 256, cur, mk_tid(wid0)); }
        if (wr == 1) PG8_BAR;
    }
    PG8_WAIT_V(0);
    PG8_BAR;
#undef MG_ITEM
#undef PG8_SA
#undef PG8_SB
#undef PG8_STG
#undef PG8_LDA
#undef PG8_LDB
#undef PG8_MMA
#undef PG8_WAIT_V
#undef PG8_WAIT_L
#undef PG8_BAR
#undef PG8_SCHED
}

}

__device__ __forceinline__ void transpose_item(const float* W, int ldw, int K, bf16_t* WT, int mode, int shift, int nvalid, float* scr, int item, int nblk, int lane, const float* gain = nullptr) {
    const int kb = item / nblk, nb = item % nblk, k0 = 64 * kb, n0 = 32 * nb;
    const int n4 = n0 + 4 * (lane & 7), kr = lane >> 3;
    int src; bool valid = true;
    if (mode == 0) { src = n4 + shift; valid = n4 < nvalid; } else { src = (n4 >> 6) * 128 + (n4 & 63) + (mode == 2 ? 64 : 0); }
    f32x4 v[8];
#pragma unroll
    for (int i = 0; i < 8; ++i) v[i] = valid ? *(const f32x4*)(W + (size_t)(k0 + 8 * i + kr) * ldw + src) : (f32x4){0.f, 0.f, 0.f, 0.f};
#pragma unroll
    for (int i = 0; i < 8; ++i) { const int kk = 8 * i + kr; const float gq = gain ? gain[k0 + kk] : 1.f; float* d = scr + kk * 33 + 4 * (lane & 7);
        d[0] = v[i][0] * gq; d[1] = v[i][1] * gq; d[2] = v[i][2] * gq; d[3] = v[i][3] * gq; }
    asm volatile("s_waitcnt lgkmcnt(0)" ::: "memory");
    const int c = lane & 7;
#pragma unroll
    for (int j = 0; j < 4; ++j) { const int n = (lane >> 3) + 8 * j; const float* s = scr + (8 * c) * 33 + n;
        u32x4 o; o.x = pk2(s[0 * 33], s[1 * 33]); o.y = pk2(s[2 * 33], s[3 * 33]); o.z = pk2(s[4 * 33], s[5 * 33]); o.w = pk2(s[6 * 33], s[7 * 33]);
        *(u32x4*)(WT + (size_t)(n0 + n) * K + k0 + 8 * c) = o; }
    asm volatile("s_waitcnt lgkmcnt(0)" ::: "memory");
}
__device__ __forceinline__ void rms_row_bf16(const float* xrow, const float* gain, bf16_t* orow, int lane) {
    const f32x4* xr = (const f32x4*)xrow + lane; const f32x4* gr = (const f32x4*)gain + lane;
    f32x4 v[4]; float s = 0.f;
#pragma unroll
    for (int j = 0; j < 4; ++j) { v[j] = xr[64 * j]; s += (v[j].x * v[j].x + v[j].y * v[j].y) + (v[j].z * v[j].z + v[j].w * v[j].w); }
    const float rstd = rsqrtf(wave_sum(s) * (1.f / DM) + EPS);
    u32x2* o8 = (u32x2*)orow + lane;
#pragma unroll
    for (int j = 0; j < 4; ++j) { const f32x4 gg = gr[64 * j]; u32x2 w; w.x = pk2(v[j].x * rstd * gg.x, v[j].y * rstd * gg.y); w.y = pk2(v[j].z * rstd * gg.z, v[j].w * rstd * gg.w); o8[64 * j] = w; }
}
__device__ __forceinline__ void rms_row_f32(float* xrow, const float* gain, int lane) {
    f32x4* xr = (f32x4*)xrow + lane; const f32x4* gr = (const f32x4*)gain + lane;
    f32x4 v[4]; float s = 0.f;
#pragma unroll
    for (int j = 0; j < 4; ++j) { v[j] = xr[64 * j]; s += (v[j].x * v[j].x + v[j].y * v[j].y) + (v[j].z * v[j].z + v[j].w * v[j].w); }
    const float rstd = rsqrtf(wave_sum(s) * (1.f / DM) + EPS);
#pragma unroll
    for (int j = 0; j < 4; ++j) xr[64 * j] = v[j] * rstd * gr[64 * j];
}

struct Args { const float* in[24]; float* out; unsigned char* ws; int ph_lo, ph_hi; };
typedef const __attribute__((address_space(4))) Args* AP;

__device__ __forceinline__ void phase_weights(int wid0, int bid, const AP A, int l, unsigned char* lds, int G) {
    const int tid = mk_tid(wid0);
    const int lane = tid & 63, wave = tid >> 6;
    float* scr = (float*)(lds + wave * 16384);
    const int gw = bid * 8 + wave, NGW = G * 8;
    unsigned char* ws = A->ws;
    const float* w_in = A->in[3] + (size_t)l * DM * IN_COLS;
    const float* w_uq = A->in[8] + (size_t)l * 384 * 768;
    const float* w_ukv = A->in[9] + (size_t)l * 256 * 1024;
    const float* w_out = A->in[19] + (size_t)l * DM * DM;
    const float* w_up = A->in[21] + (size_t)l * DM * DFF;
    const float* w_dn = A->in[22] + (size_t)l * DFF * DM;
    constexpr int I0 = 16 * 128, I1 = 16 * 96, I2 = 6 * 24, I3 = 4 * 16, I4 = 4 * 16, I5 = 8 * 32, I8 = 16 * 32, I9 = 16 * 128, I10 = 64 * 32;
    constexpr int NIT = I0 + I1 + I2 + I3 + I4 + 3 * I5 + I8 + I9 + I10;
    for (int it = gw; it < NIT; it += NGW) {
        int r = it;
        if (r < I0) { transpose_item(w_in, IN_COLS, DM, (bf16_t*)(ws + WS_WIN), 0, 0, NPROJ, scr, r, 128, lane, A->in[2] + l * DM); continue; } r -= I0;
        if (r < I1) { transpose_item(w_in, IN_COLS, DM, (bf16_t*)(ws + WS_WIN) + (size_t)4096 * DM, 0, NPROJ, 1 << 30, scr, r, 96, lane, A->in[2] + l * DM); continue; } r -= I1;
        if (r < I2) { transpose_item(w_uq, 768, 384, (bf16_t*)(ws + WS_WUQ), 0, 0, 1 << 30, scr, r, 24, lane); continue; } r -= I2;
        if (r < I3) { transpose_item(w_ukv, 1024, 256, (bf16_t*)(ws + WS_WUK), 1, 0, 0, scr, r, 16, lane); continue; } r -= I3;
        if (r < I4) { transpose_item(w_ukv, 1024, 256, (bf16_t*)(ws + WS_WUV), 2, 0, 0, scr, r, 16, lane); continue; } r -= I4;
        if (r < 3 * I5) { const int i = r / I5; const float* wb = A->in[16 + i] + (size_t)l * 512 * DM;
            transpose_item(wb, DM, 512, (bf16_t*)(ws + WS_WBR) + (size_t)i * DM * 512, 0, 0, 1 << 30, scr, r % I5, 32, lane); continue; } r -= 3 * I5;
        if (r < I8) { transpose_item(w_out, DM, DM, (bf16_t*)(ws + WS_WOUT), 0, 0, 1 << 30, scr, r, 32, lane); continue; } r -= I8;
        if (r < I9) { transpose_item(w_up, DFF, DM, (bf16_t*)(ws + WS_WUP), 0, 0, 1 << 30, scr, r, 128, lane, A->in[20] + l * DM); continue; } r -= I9;
        transpose_item(w_dn, DM, DFF, (bf16_t*)(ws + WS_WDN), 0, 0, 1 << 30, scr, r, 32, lane);
    }
    if (l == 0) {
        const int* pos = (const int*)A->in[1]; float* rope = (float*)(ws + WS_ROPE);
        for (int e = bid * 512 + tid; e < MTOK * 16; e += G * 512) {
            const int row = e >> 4, i = e & 15;
            const float inv = exp2f(-(float)(2 * i) * (1.f / 32.f) * 13.287712379549449f);
            const float ang = (float)pos[row] * inv;
            double t = (double)ang * 0.15915494309189535; t -= rint(t);
            rope[row * 32 + i] = __builtin_amdgcn_cosf((float)t); rope[row * 32 + 16 + i] = __builtin_amdgcn_sinf((float)t);
        }
        if (bid == 0) { const float* lg = A->in[4]; float* lbs = (float*)(ws + WS_LBS); const int j = tid;
            const float a0 = lg[j], a1 = lg[512 + j], a2 = lg[1024 + j], a3 = lg[1536 + j]; const float mx = fmaxf(fmaxf(a0, a1), fmaxf(a2, a3));
            const float e0 = __expf(a0 - mx), e1 = __expf(a1 - mx), e2 = __expf(a2 - mx), e3 = __expf(a3 - mx); const float inv = 1.f / (e0 + e1 + e2 + e3);
            lbs[j] = 0.f; lbs[512 + j] = e1 * inv; lbs[1024 + j] = (e1 + e2) * inv; lbs[1536 + j] = (e1 + e2 + e3) * inv; }
    }
}
__device__ __forceinline__ void phase_xcast(int wid0, int bid, const float* x, bf16_t* XB, float* ssq, int G) {
    const int tid = mk_tid(wid0); const int lane = tid & 63, gw = bid * 8 + (tid >> 6), NGW = G * 8;
    for (int m0 = gw * 2; m0 < MTOK; m0 += NGW * 2) { f32x4 v[2][4];
#pragma unroll
        for (int i = 0; i < 2; ++i) { const f32x4* xr = (const f32x4*)(x + (size_t)(m0 + i) * DM) + lane;
#pragma unroll
            for (int j = 0; j < 4; ++j) v[i][j] = xr[64 * j]; }
#pragma unroll
        for (int i = 0; i < 2; ++i) { const int m = m0 + i; u32x2* o8 = (u32x2*)(XB + (size_t)m * DM) + lane; float s = 0.f;
#pragma unroll
            for (int j = 0; j < 4; ++j) { const f32x4 vv = v[i][j]; s += (vv.x * vv.x + vv.y * vv.y) + (vv.z * vv.z + vv.w * vv.w); u32x2 w; w.x = pk2(vv.x, vv.y); w.y = pk2(vv.z, vv.w); o8[64 * j] = w; }
            s = wave_sum(s); if (lane < 16) ssq[(size_t)m * 16 + lane] = lane == 0 ? s : 0.f; } }
}
__device__ __forceinline__ void phase_zero(int wid0, int bid, float* p, int n, int G) { const int tid = mk_tid(wid0); for (int i = bid * 512 + tid; i < n; i += G * 512) p[i] = 0.f; }
__device__ __forceinline__ void phase_rmsnorm(int wid0, int bid, const float* x, const float* gain, bf16_t* H, int G) {
    const int tid = mk_tid(wid0);
    const int lane = tid & 63, gw = bid * 8 + (tid >> 6), NGW = G * 8;
    for (int m = gw; m < MTOK; m += NGW) rms_row_bf16(x + (size_t)m * DM, gain, H + (size_t)m * DM, lane);
}
__device__ __forceinline__ void phase_elem(int wid0, int bid, bf16_t* P, const float* qn, const float* kvn, const float* rope, bf16_t* KRP, int G) {
    const int tid = mk_tid(wid0);
    const int lane = tid & 63, gw = bid * 8 + (tid >> 6), NGW = G * 8;
    float gq[6], gk[4];
#pragma unroll
    for (int j = 0; j < 3; ++j) { gq[2 * j] = qn[2 * lane + 128 * j]; gq[2 * j + 1] = qn[2 * lane + 128 * j + 1]; }
#pragma unroll
    for (int j = 0; j < 2; ++j) { gk[2 * j] = kvn[2 * lane + 128 * j]; gk[2 * j + 1] = kvn[2 * lane + 128 * j + 1]; }
    for (int m0 = gw * 4; m0 < MTOK; m0 += NGW * 4) {
        unsigned wq[4][3], wk[4][2]; unsigned k1[4], k2[4]; float rc[4], rsn[4];
#pragma unroll
        for (int i = 0; i < 4; ++i) { bf16_t* row = P + (size_t)(m0 + i) * LDP; const unsigned* pq = (const unsigned*)(row + C_CQ) + lane; const unsigned* pk = (const unsigned*)(row + C_CKV) + lane;
#pragma unroll
            for (int j = 0; j < 3; ++j) wq[i][j] = pq[64 * j];
#pragma unroll
            for (int j = 0; j < 2; ++j) wk[i][j] = pk[64 * j];
            k1[i] = row[C_KR + (lane & 15)]; k2[i] = row[C_KR + 16 + (lane & 15)]; rc[i] = rope[(size_t)(m0 + i) * 32 + (lane & 15)]; rsn[i] = rope[(size_t)(m0 + i) * 32 + 16 + (lane & 15)]; }
#pragma unroll
        for (int i = 0; i < 4; ++i) { bf16_t* row = P + (size_t)(m0 + i) * LDP; unsigned* pq = (unsigned*)(row + C_CQ) + lane; unsigned* pk = (unsigned*)(row + C_CKV) + lane;
            float s = 0.f;
#pragma unroll
            for (int j = 0; j < 3; ++j) { const float a = bf2f(wq[i][j] & 0xffffu), b = bf2f(wq[i][j] >> 16); s += a * a + b * b; }
            const float rq = rsqrtf(wave_sum(s) * (1.f / 384.f) + EPS);
#pragma unroll
            for (int j = 0; j < 3; ++j) pq[64 * j] = pk2(bf2f(wq[i][j] & 0xffffu) * rq * gq[2 * j], bf2f(wq[i][j] >> 16) * rq * gq[2 * j + 1]);
            float s2 = 0.f;
#pragma unroll
            for (int j = 0; j < 2; ++j) { const float a = bf2f(wk[i][j] & 0xffffu), b = bf2f(wk[i][j] >> 16); s2 += a * a + b * b; }
            const float rk = rsqrtf(wave_sum(s2) * (1.f / 256.f) + EPS);
#pragma unroll
            for (int j = 0; j < 2; ++j) pk[64 * j] = pk2(bf2f(wk[i][j] & 0xffffu) * rk * gk[2 * j], bf2f(wk[i][j] >> 16) * rk * gk[2 * j + 1]);
            if (lane < 16) { const float x1 = bf2f(k1[i]), x2 = bf2f(k2[i]);
                KRP[(size_t)(m0 + i) * 32 + lane] = (bf16_t)f2bf(x1 * rc[i] - x2 * rsn[i]); KRP[(size_t)(m0 + i) * 32 + 16 + lane] = (bf16_t)f2bf(x2 * rc[i] + x1 * rsn[i]); } }
    }
}

__device__ __forceinline__ void hgrn_gate(float ff, float lb, float oml, float& logf, float& kk) {
    ff = fminf(fmaxf(ff, -30.f), 30.f);
    const float e = __expf(-ff), sg = __builtin_amdgcn_rcpf(1.f + e);
    logf = __logf(lb + oml * sg); kk = oml * e * sg;
}
__device__ __forceinline__ void hgrn_pass1(int wid0, int bid, unsigned char* lds, const bf16_t* P, const float* lbs, bf16_t* HST, float* HGD, int G) {
    bf16_t* KbT = (bf16_t*)lds; bf16_t* VT = (bf16_t*)(lds + 18432); float* tot = (float*)(lds + 36864);
    unsigned rf[16], rvv[16];
#define HG1_LOAD(uu, tid_) do { const int kc_ = (tid_) & 127, rg_ = (tid_) >> 7; const size_t r0_ = (size_t)((uu) >> 8) * SEQ + ((uu) & 63) * 64 + rg_ * 16; const bf16_t* p_ = P + r0_ * LDP + (((uu) >> 6) & 3) * 128 + kc_; \
        _Pragma("unroll") for (int r = 0; r < 16; ++r) { rf[r] = p_[(size_t)r * LDP + C_HF]; rvv[r] = p_[(size_t)r * LDP + C_HI]; } } while (0)
    if (bid < 2048) { const int t0 = mk_tid(wid0); HG1_LOAD(bid, t0); }
    for (int u = bid; u < 2048; u += G) {
        const int tid = mk_tid(wid0);
        const int lane = tid & 63, wid = tid >> 6, r32 = lane & 31, hh = lane >> 5, kc = tid & 127, rg = tid >> 7;
        const int h = (u >> 6) & 3;
        const float lb = lbs[h * 128 + kc], oml = 1.f - lb;
        float bb[16], kk[16]; unsigned vv[16]; float run = 0.f;
#pragma unroll
        for (int r = 0; r < 16; ++r) { const float ff = bf2f(rf[r]); vv[r] = rvv[r]; float lf; hgrn_gate(ff, lb, oml, lf, kk[r]); run += lf; bb[r] = run; }
        if (u + G < 2048) HG1_LOAD(u + G, tid);
        tot[rg * 128 + kc] = run; __syncthreads();
        float off = 0.f, blast = 0.f;
#pragma unroll
        for (int g = 0; g < 4; ++g) { const float t = tot[g * 128 + kc]; if (g < rg) off += t; blast += t; }
        unsigned kw[8], vw[8];
#pragma unroll
        for (int r = 0; r < 16; r += 2) { const float k0 = kk[r] * __expf(blast - (bb[r] + off)), k1 = kk[r + 1] * __expf(blast - (bb[r + 1] + off));
            kw[r >> 1] = pk2(k0, k1); vw[r >> 1] = vv[r] | (vv[r + 1] << 16); }
        *(u32x4*)(KbT + kc * 72 + rg * 16) = (u32x4){kw[0], kw[1], kw[2], kw[3]}; *(u32x4*)(KbT + kc * 72 + rg * 16 + 8) = (u32x4){kw[4], kw[5], kw[6], kw[7]};
        *(u32x4*)(VT + kc * 72 + rg * 16) = (u32x4){vw[0], vw[1], vw[2], vw[3]}; *(u32x4*)(VT + kc * 72 + rg * 16 + 8) = (u32x4){vw[4], vw[5], vw[6], vw[7]};
        if (rg == 0) HGD[u * 128 + kc] = __expf(blast);
        __syncthreads();
        const int kb = wid >> 1, vb0 = (wid & 1) * 2;
        f32x16 a0 = {}, a1 = {};
#pragma unroll
        for (int s = 0; s < 4; ++s) { const bf16x8 a = *(const bf16x8*)(KbT + (kb * 32 + r32) * 72 + 16 * s + 8 * hh);
            const bf16x8 b0 = *(const bf16x8*)(VT + (vb0 * 32 + r32) * 72 + 16 * s + 8 * hh), b1 = *(const bf16x8*)(VT + ((vb0 + 1) * 32 + r32) * 72 + 16 * s + 8 * hh);
            a0 = MFMA32(a, b0, a0); a1 = MFMA32(a, b1, a1); }
        bf16_t* st = HST + (size_t)u * 16384;
#pragma unroll
        for (int q = 0; q < 4; ++q) { u32x2 w0, w1; w0.x = cvt_pk_bf16(a0[4 * q], a0[4 * q + 1]); w0.y = cvt_pk_bf16(a0[4 * q + 2], a0[4 * q + 3]); w1.x = cvt_pk_bf16(a1[4 * q], a1[4 * q + 1]); w1.y = cvt_pk_bf16(a1[4 * q + 2], a1[4 * q + 3]);
            *(u32x2*)(st + (vb0 * 32 + r32) * 128 + kb * 32 + 8 * q + 4 * hh) = w0; *(u32x2*)(st + ((vb0 + 1) * 32 + r32) * 128 + kb * 32 + 8 * q + 4 * hh) = w1; }
        __syncthreads();
    }
}
__device__ __forceinline__ void hgrn_scan(int wid0, int bid, bf16_t* HST, const float* HGD, int G) {
    const int tid = mk_tid(wid0);
    for (int gt = bid * 512 + tid; gt < 131072; gt += G * 512) {
        const int e0 = gt * 4, bh = e0 >> 14, idx = e0 & 16383, k = idx & 127;
        float S0 = 0.f, S1 = 0.f, S2 = 0.f, S3 = 0.f;
#pragma unroll 16
        for (int c = 0; c < 64; ++c) { const int u = bh * 64 + c; u32x2* ptr = (u32x2*)(HST + (size_t)u * 16384 + idx); const u32x2 d = *ptr; const f32x4 dv = *(const f32x4*)(HGD + u * 128 + k);
            u32x2 w; w.x = pk2(S0, S1); w.y = pk2(S2, S3); *ptr = w;
            S0 = dv.x * S0 + bf2f(d.x & 0xffffu); S1 = dv.y * S1 + bf2f(d.x >> 16); S2 = dv.z * S2 + bf2f(d.y & 0xffffu); S3 = dv.w * S3 + bf2f(d.y >> 16); }
    }
}
__device__ __forceinline__ void hgrn_pass3(int wid0, int bid, unsigned char* lds, bf16_t* yo, int ypitch, bf16_t* P, const float* lbs, const float* ngain, const bf16_t* HST, int G) {
    bf16_t* QD = (bf16_t*)lds; bf16_t* KD = (bf16_t*)(lds + 17408); bf16_t* QB = (bf16_t*)(lds + 34816); bf16_t* QO = (bf16_t*)(lds + 52224); bf16_t* KO = (bf16_t*)(lds + 60928);
    bf16_t* VT = (bf16_t*)(lds + 69632); float* tot = (float*)(lds + 88064); float* ssq = (float*)(lds + 90112);
    unsigned rq[16], rf[16], rvv[16];
#define HG3_LOAD(uu, tid_) do { const int kc_ = (tid_) & 127, rg_ = (tid_) >> 7; const size_t r0_ = (size_t)((uu) >> 8) * SEQ + ((uu) & 63) * 64 + rg_ * 16; const bf16_t* p_ = P + r0_ * LDP + (((uu) >> 6) & 3) * 128 + kc_; \
        _Pragma("unroll") for (int r = 0; r < 16; ++r) { rq[r] = p_[(size_t)r * LDP + C_HQ]; rf[r] = p_[(size_t)r * LDP + C_HF]; rvv[r] = p_[(size_t)r * LDP + C_HI]; } } while (0)
    if (bid < 2048) { const int t0 = mk_tid(wid0); HG3_LOAD(bid, t0); }
    for (int u = bid; u < 2048; u += G) {
        const int tid = mk_tid(wid0);
        const int lane = tid & 63, wid = tid >> 6, r32 = lane & 31, hh = lane >> 5, kc = tid & 127, rg = tid >> 7;
        const int b = u >> 8, h = (u >> 6) & 3, c = u & 63;
        const size_t rowc = (size_t)b * SEQ + c * 64;
        const float lb = lbs[h * 128 + kc], oml = 1.f - lb;
        float bb[16], kk[16], qq[16]; unsigned vw[8]; float run = 0.f;
#pragma unroll
        for (int r = 0; r < 16; r += 2) {
            const float f0 = bf2f(rf[r]), f1 = bf2f(rf[r + 1]); vw[r >> 1] = rvv[r] | (rvv[r + 1] << 16);
            qq[r] = siluf_(bf2f(rq[r])); qq[r + 1] = siluf_(bf2f(rq[r + 1]));
            float lf; hgrn_gate(f0, lb, oml, lf, kk[r]); run += lf; bb[r] = run; hgrn_gate(f1, lb, oml, lf, kk[r + 1]); run += lf; bb[r + 1] = run; }
        if (u + G < 2048) HG3_LOAD(u + G, tid);
        u32x2 gpre[4];
        { const bf16_t* pg = P + (rowc + (wid >> 2) * 32 + r32) * LDP + C_HG + h * 128 + (wid & 3) * 32 + 4 * hh;
#pragma unroll
          for (int q = 0; q < 4; ++q) gpre[q] = *(const u32x2*)(pg + 8 * q); }
        bf16x8 spre[8];
        { const bf16_t* st = HST + (size_t)u * 16384 + ((wid & 3) * 32 + r32) * 128 + 8 * hh;
#pragma unroll
          for (int s8 = 0; s8 < 8; ++s8) spre[s8] = *(const bf16x8*)(st + 16 * s8); }
        tot[rg * 128 + kc] = run; __syncthreads();
        const float t0 = tot[kc], t1 = tot[128 + kc], t2 = tot[256 + kc];
        const float G0 = t0, G1 = t0 + t1, G2 = G1 + t2;
        const float off = rg == 0 ? 0.f : (rg == 1 ? G0 : (rg == 2 ? G1 : G2));
        const float refD = rg < 2 ? G0 : G2;
        *(u32x4*)(VT + kc * 72 + rg * 16) = (u32x4){vw[0], vw[1], vw[2], vw[3]}; *(u32x4*)(VT + kc * 72 + rg * 16 + 8) = (u32x4){vw[4], vw[5], vw[6], vw[7]};
        const float eD = __expf(refD), eO = rg >= 2 ? __expf(refD - G1) : __expf(G1 - refD);
#pragma unroll
        for (int r = 0; r < 16; ++r) { const int i = rg * 16 + r; const float bi = bb[r] + off;
            const float qe = qq[r] * __expf(fminf(bi - refD, 80.f)), ke = kk[r] * __expf(fminf(refD - bi, 80.f));
            QD[i * 136 + kc] = (bf16_t)f2bf(qe); KD[i * 136 + kc] = (bf16_t)f2bf(ke);
            QB[i * 136 + kc] = (bf16_t)f2bf(qe * eD);
            if (rg >= 2) QO[(i - 32) * 136 + kc] = (bf16_t)f2bf(qe * eO); else KO[i * 136 + kc] = (bf16_t)f2bf(ke * eO); }
        __syncthreads();
        const int vb = wid & 3, ib = wid >> 2;
        f32x16 o = {};
        {
#pragma unroll
          for (int s = 0; s < 8; ++s) { const bf16x8 a = spre[s]; const bf16x8 bq = *(const bf16x8*)(QB + (ib * 32 + r32) * 136 + 16 * s + 8 * hh); o = MFMA32(a, bq, o); } }
        { f32x16 at = {};
#pragma unroll
          for (int s = 0; s < 8; ++s) { const bf16x8 a = *(const bf16x8*)(KD + (ib * 32 + r32) * 136 + 16 * s + 8 * hh); const bf16x8 bq = *(const bf16x8*)(QD + (ib * 32 + r32) * 136 + 16 * s + 8 * hh); at = MFMA32(a, bq, at); }
#pragma unroll
          for (int r = 0; r < 16; ++r) if (crow(r, hh) > r32) at[r] = 0.f;
#pragma unroll
          for (int s2 = 0; s2 < 2; ++s2) { const bf16x8 bf = pack8(at, s2); const unsigned char* vp = (const unsigned char*)(VT + (vb * 32 + r32) * 72 + ib * 32 + 16 * s2 + 4 * hh);
              o = MFMA32(ld2x64(vp, vp + 16), bf, o); } }
        if (ib == 1) { f32x16 at = {};
#pragma unroll
          for (int s = 0; s < 8; ++s) { const bf16x8 a = *(const bf16x8*)(KO + r32 * 136 + 16 * s + 8 * hh); const bf16x8 bq = *(const bf16x8*)(QO + r32 * 136 + 16 * s + 8 * hh); at = MFMA32(a, bq, at); }
#pragma unroll
          for (int s2 = 0; s2 < 2; ++s2) { const bf16x8 bf = pack8(at, s2); const unsigned char* vp = (const unsigned char*)(VT + (vb * 32 + r32) * 72 + 16 * s2 + 4 * hh);
              o = MFMA32(ld2x64(vp, vp + 16), bf, o); } }
        float sq = 0.f;
#pragma unroll
        for (int r = 0; r < 16; ++r) sq += o[r] * o[r];
        sq += __shfl_xor(sq, 32);
        if (hh == 0) ssq[(ib * 32 + r32) * 4 + vb] = sq;
        __syncthreads();
        const f32x4 sv = *(const f32x4*)(ssq + (ib * 32 + r32) * 4);
        const float rstd = rsqrtf((sv.x + sv.y + sv.z + sv.w) * (1.f / 128.f) + EPS);
        bf16_t* prow = P + (rowc + ib * 32 + r32) * LDP;
#pragma unroll
        for (int q = 0; q < 4; ++q) { const int v0 = h * 128 + vb * 32 + 8 * q + 4 * hh; const u32x2 gw = gpre[q]; const f32x4 ng = *(const f32x4*)(ngain + v0);
            const float y0 = o[4 * q] * rstd * ng.x * siluf_(bf2f(gw.x & 0xffffu)), y1 = o[4 * q + 1] * rstd * ng.y * siluf_(bf2f(gw.x >> 16));
            const float y2 = o[4 * q + 2] * rstd * ng.z * siluf_(bf2f(gw.y & 0xffffu)), y3 = o[4 * q + 3] * rstd * ng.w * siluf_(bf2f(gw.y >> 16));
            u32x2 w; w.x = pk2(y0, y1); w.y = pk2(y2, y3); *(u32x2*)(yo + (rowc + ib * 32 + r32) * ypitch + v0) = w; }
        __syncthreads();
    }
}

__device__ __forceinline__ float softplusf_(float x) { if (x > 15.f) return x; const float e = __expf(x); return e < 1e-3f ? e * (1.f - 0.5f * e) : __logf(1.f + e); }
__device__ __forceinline__ void mamba_dt(int tid, const bf16_t* P, size_t row0, int g, const float* dt_bias, const float* a_log, float* dtv, float* acum, float* wtot) {
    const int lane = tid & 63, wid = tid >> 6; const int hl = wid >> 1, l = (wid & 1) * 64 + lane, head = g * 4 + hl;
    const float dt = softplusf_(bf2f(P[(row0 + l) * LDP + C_DT + head]) + dt_bias[head]);
    float v = -__expf(a_log[head]) * dt;
#pragma unroll
    for (int o = 1; o < 64; o <<= 1) { const float t = __shfl_up(v, o); if (lane >= o) v += t; }
    if (lane == 63) wtot[wid] = v;
    __syncthreads();
    if (wid & 1) v += wtot[wid - 1];
    acum[hl * 128 + l] = v; dtv[hl * 128 + l] = dt;
    __syncthreads();
}
__device__ __forceinline__ void mamba_pass1(int wid0, int bid, unsigned char* lds, const bf16_t* P, const float* cw, const float* cb, const float* dt_bias, const float* a_log, bf16_t* MS, float* MAT, int G) {
    bf16_t* XwT = (bf16_t*)lds; bf16_t* BT = (bf16_t*)(lds + 69632); float* dtv = (float*)(lds + 87040); float* acum = (float*)(lds + 89088); float* wtot = (float*)(lds + 91136);
    for (int u = bid; u < 512; u += G) {
        const int tid = mk_tid(wid0);
        const int lane = tid & 63, wid = tid >> 6, r32 = lane & 31, hh = lane >> 5;
        const int b = u >> 6, c = (u >> 1) & 31, g = u & 1; const size_t row0 = (size_t)b * SEQ + c * 128;
        const int ch = tid & 255, rh = tid >> 8, chanx = g * 256 + ch, hlx = ch >> 6, lx0 = rh * 64;
        const bf16_t* pxx = P + row0 * LDP + C_XBC + chanx; const int tokx = c * 128 + lx0;
        unsigned rx[64]; unsigned hx3 = 0, hx2 = 0, hx1 = 0;
        if (tokx >= 3) { hx3 = pxx[(ptrdiff_t)(lx0 - 3) * LDP]; hx2 = pxx[(ptrdiff_t)(lx0 - 2) * LDP]; hx1 = pxx[(ptrdiff_t)(lx0 - 1) * LDP]; }
#pragma unroll
        for (int i = 0; i < 64; ++i) rx[i] = pxx[(size_t)(lx0 + i) * LDP];
        const int nB = tid & 63, rgp = tid >> 6, chanb = 512 + g * 64 + nB, lb0 = rgp * 16;
        const bf16_t* pxb = P + row0 * LDP + C_XBC + chanb; const int tokb = c * 128 + lb0;
        unsigned rb[16]; unsigned hb3 = 0, hb2 = 0, hb1 = 0;
        if (tokb >= 3) { hb3 = pxb[(ptrdiff_t)(lb0 - 3) * LDP]; hb2 = pxb[(ptrdiff_t)(lb0 - 2) * LDP]; hb1 = pxb[(ptrdiff_t)(lb0 - 1) * LDP]; }
#pragma unroll
        for (int i = 0; i < 16; ++i) rb[i] = pxb[(size_t)(lb0 + i) * LDP];
        const float wx0 = cw[chanx], wx1 = cw[768 + chanx], wx2 = cw[1536 + chanx], wx3 = cw[2304 + chanx], bx = cb[chanx];
        const float wb0 = cw[chanb], wb1 = cw[768 + chanb], wb2 = cw[1536 + chanb], wb3 = cw[2304 + chanb], bbv = cb[chanb];
        mamba_dt(tid, P, row0, g, dt_bias, a_log, dtv, acum, wtot);
        { float x3 = bf2f(hx3), x2 = bf2f(hx2), x1 = bf2f(hx1); const float alast = acum[hlx * 128 + 127];
#pragma unroll
          for (int k8 = 0; k8 < 8; ++k8) { unsigned w[4];
#pragma unroll
              for (int e = 0; e < 8; e += 2) { float xv[2];
#pragma unroll
                  for (int e2 = 0; e2 < 2; ++e2) { const int l = lx0 + k8 * 8 + e + e2; const float xin = bf2f(rx[k8 * 8 + e + e2]); const float cv = wx0 * x3 + wx1 * x2 + wx2 * x1 + wx3 * xin + bx; x3 = x2; x2 = x1; x1 = xin;
                      xv[e2] = siluf_(cv) * dtv[hlx * 128 + l] * __expf(alast - acum[hlx * 128 + l]); }
                  w[e >> 1] = pk2(xv[0], xv[1]); }
              *(u32x4*)(XwT + ch * 136 + lx0 + k8 * 8) = (u32x4){w[0], w[1], w[2], w[3]}; } }
        { float x3 = bf2f(hb3), x2 = bf2f(hb2), x1 = bf2f(hb1); unsigned w[8];
#pragma unroll
          for (int e = 0; e < 16; e += 2) { float xv[2];
#pragma unroll
              for (int e2 = 0; e2 < 2; ++e2) { const float xin = bf2f(rb[e + e2]); const float cv = wb0 * x3 + wb1 * x2 + wb2 * x1 + wb3 * xin + bbv; x3 = x2; x2 = x1; x1 = xin; xv[e2] = siluf_(cv); }
              w[e >> 1] = pk2(xv[0], xv[1]); }
          *(u32x4*)(BT + nB * 136 + lb0) = (u32x4){w[0], w[1], w[2], w[3]}; *(u32x4*)(BT + nB * 136 + lb0 + 8) = (u32x4){w[4], w[5], w[6], w[7]}; }
        __syncthreads();
        { const int hl = wid >> 1, nb = wid & 1, head = g * 4 + hl;
          f32x16 a0 = {}, a1 = {};
#pragma unroll
          for (int s = 0; s < 8; ++s) { const bf16x8 a = *(const bf16x8*)(BT + (nb * 32 + r32) * 136 + 16 * s + 8 * hh);
              const bf16x8 b0 = *(const bf16x8*)(XwT + (hl * 64 + r32) * 136 + 16 * s + 8 * hh), b1 = *(const bf16x8*)(XwT + (hl * 64 + 32 + r32) * 136 + 16 * s + 8 * hh);
              a0 = MFMA32(a, b0, a0); a1 = MFMA32(a, b1, a1); }
          bf16_t* ms = MS + (size_t)((b * 32 + c) * 8 + head) * 4096;
#pragma unroll
          for (int q = 0; q < 4; ++q) { u32x2 w0, w1; w0.x = cvt_pk_bf16(a0[4 * q], a0[4 * q + 1]); w0.y = cvt_pk_bf16(a0[4 * q + 2], a0[4 * q + 3]); w1.x = cvt_pk_bf16(a1[4 * q], a1[4 * q + 1]); w1.y = cvt_pk_bf16(a1[4 * q + 2], a1[4 * q + 3]);
              *(u32x2*)(ms + r32 * 64 + nb * 32 + 8 * q + 4 * hh) = w0; *(u32x2*)(ms + (32 + r32) * 64 + nb * 32 + 8 * q + 4 * hh) = w1; }
          if (tid < 4) MAT[(b * 32 + c) * 8 + g * 4 + tid] = acum[tid * 128 + 127]; }
        __syncthreads();
    }
}
__device__ __forceinline__ void mamba_scan(int wid0, int bid, bf16_t* MS, const float* MAT, int G) {
    const int tid = mk_tid(wid0);
    for (int gt = bid * 512 + tid; gt < 131072; gt += G * 512) {
        const int e0 = gt * 2, bhd = e0 >> 12, b = bhd >> 3, head = bhd & 7, idx = e0 & 4095;
        float S0 = 0.f, S1 = 0.f;
#pragma unroll 16
        for (int c = 0; c < 32; ++c) { const int ui = (b * 32 + c) * 8 + head; unsigned* ptr = (unsigned*)(MS + (size_t)ui * 4096 + idx); const unsigned d = *ptr; const float dec = __expf(MAT[ui]);
            *ptr = pk2(S0, S1);
            S0 = dec * S0 + bf2f(d & 0xffffu); S1 = dec * S1 + bf2f(d >> 16); }
    }
}
__device__ __forceinline__ void mamba_pass3(int wid0, int bid, unsigned char* lds, bf16_t* yo, int ypitch, bf16_t* P, const float* cw, const float* cb, const float* dt_bias, const float* a_log, const float* dsk, const float* ngain, const bf16_t* MS, int G) {
    bf16_t* XT = (bf16_t*)lds; bf16_t* Brow = (bf16_t*)(lds + 69632); bf16_t* Crow = (bf16_t*)(lds + 88064);
    float* dtv = (float*)(lds + 106496); float* acum = (float*)(lds + 108544); float* ssq = (float*)(lds + 110592); float* wtot = (float*)(lds + 111616);
    for (int u = bid; u < 512; u += G) {
        const int tid = mk_tid(wid0);
        const int lane = tid & 63, wid = tid >> 6, r32 = lane & 31, hh = lane >> 5;
        const int b = u >> 6, c = (u >> 1) & 31, g = u & 1; const size_t row0 = (size_t)b * SEQ + c * 128;
        const int ch = tid & 255, rh = tid >> 8, chanx = g * 256 + ch, lx0 = rh * 64;
        const bf16_t* pxx = P + row0 * LDP + C_XBC + chanx; const int tokx = c * 128 + lx0;
        unsigned rx[64]; unsigned hx3 = 0, hx2 = 0, hx1 = 0;
        if (tokx >= 3) { hx3 = pxx[(ptrdiff_t)(lx0 - 3) * LDP]; hx2 = pxx[(ptrdiff_t)(lx0 - 2) * LDP]; hx1 = pxx[(ptrdiff_t)(lx0 - 1) * LDP]; }
#pragma unroll
        for (int i = 0; i < 64; ++i) rx[i] = pxx[(size_t)(lx0 + i) * LDP];
        const int nB = tid & 63, rgp = tid >> 6, lb0 = rgp * 16; const int tokb = c * 128 + lb0;
        const bf16_t* pxb = P + row0 * LDP + C_XBC + 512 + g * 64 + nB;
        unsigned rb[2][16]; unsigned hb[2][3] = {{0, 0, 0}, {0, 0, 0}};
#pragma unroll
        for (int wh = 0; wh < 2; ++wh) {
            if (tokb >= 3) { hb[wh][0] = pxb[(ptrdiff_t)(lb0 - 3) * LDP + wh * 128]; hb[wh][1] = pxb[(ptrdiff_t)(lb0 - 2) * LDP + wh * 128]; hb[wh][2] = pxb[(ptrdiff_t)(lb0 - 1) * LDP + wh * 128]; }
#pragma unroll
            for (int i = 0; i < 16; ++i) rb[wh][i] = pxb[(size_t)(lb0 + i) * LDP + wh * 128]; }
        const float wx0 = cw[chanx], wx1 = cw[768 + chanx], wx2 = cw[1536 + chanx], wx3 = cw[2304 + chanx], bx = cb[chanx];
        mamba_dt(tid, P, row0, g, dt_bias, a_log, dtv, acum, wtot);
        { float x3 = bf2f(hx3), x2 = bf2f(hx2), x1 = bf2f(hx1);
#pragma unroll
          for (int k8 = 0; k8 < 8; ++k8) { unsigned w[4];
#pragma unroll
              for (int e = 0; e < 8; e += 2) { float xv[2];
#pragma unroll
                  for (int e2 = 0; e2 < 2; ++e2) { const float xin = bf2f(rx[k8 * 8 + e + e2]); const float cv = wx0 * x3 + wx1 * x2 + wx2 * x1 + wx3 * xin + bx; x3 = x2; x2 = x1; x1 = xin; xv[e2] = siluf_(cv); }
                  w[e >> 1] = pk2(xv[0], xv[1]); }
              *(u32x4*)(XT + ch * 136 + lx0 + k8 * 8) = (u32x4){w[0], w[1], w[2], w[3]}; } }
#pragma unroll
        for (int wh = 0; wh < 2; ++wh) { const int chan = 512 + wh * 128 + g * 64 + nB; bf16_t* dst = wh ? Crow : Brow;
            const float w0 = cw[chan], w1 = cw[768 + chan], w2 = cw[1536 + chan], w3 = cw[2304 + chan], bias = cb[chan];
            float x3 = bf2f(hb[wh][0]), x2 = bf2f(hb[wh][1]), x1 = bf2f(hb[wh][2]);
#pragma unroll
            for (int e = 0; e < 16; ++e) { const float xin = bf2f(rb[wh][e]); const float cv = w0 * x3 + w1 * x2 + w2 * x1 + w3 * xin + bias; x3 = x2; x2 = x1; x1 = xin;
                dst[(lb0 + e) * 72 + nB] = (bf16_t)f2bf(siluf_(cv)); } }
        __syncthreads();
        const int lblk = wid & 3, hp = wid >> 2;
        f32x16 y[2][2] = {};
        for (int sb = 0; sb <= lblk; ++sb) {
            f32x16 gt = {};
#pragma unroll
            for (int s = 0; s < 4; ++s) { const bf16x8 a = *(const bf16x8*)(Brow + (sb * 32 + r32) * 72 + 16 * s + 8 * hh); const bf16x8 bq = *(const bf16x8*)(Crow + (lblk * 32 + r32) * 72 + 16 * s + 8 * hh); gt = MFMA32(a, bq, gt); }
#pragma unroll
            for (int hi2 = 0; hi2 < 2; ++hi2) { const int hl = 2 * hp + hi2; const float al = acum[hl * 128 + lblk * 32 + r32]; const float dk = dsk[g * 4 + hl];
                f32x16 m;
#pragma unroll
                for (int r = 0; r < 16; ++r) { const int sl = crow(r, hh); const float v = gt[r] * __expf(al - acum[hl * 128 + sb * 32 + sl]) * dtv[hl * 128 + sb * 32 + sl];
                    m[r] = (sb < lblk || sl < r32) ? v : (sl == r32 ? v + dk : 0.f); }
#pragma unroll
                for (int s2 = 0; s2 < 2; ++s2) { const bf16x8 bf = pack8(m, s2);
#pragma unroll
                    for (int pb = 0; pb < 2; ++pb) { const unsigned char* xp = (const unsigned char*)(XT + (hl * 64 + pb * 32 + r32) * 136 + sb * 32 + 16 * s2 + 4 * hh); y[hi2][pb] = MFMA32(ld2x64(xp, xp + 16), bf, y[hi2][pb]); } } asm volatile("" ::: "memory"); }
        }
#pragma unroll
        for (int hi2 = 0; hi2 < 2; ++hi2) { const int hl = 2 * hp + hi2, head = g * 4 + hl; const float ea = __expf(acum[hl * 128 + lblk * 32 + r32]);
#pragma unroll
            for (int pb = 0; pb < 2; ++pb) { f32x16 t = {}; const bf16_t* sp = MS + ((size_t)((b * 32 + c) * 8 + head) * 64 + pb * 32 + r32) * 64;
#pragma unroll
                for (int s = 0; s < 4; ++s) { const bf16x8 a = *(const bf16x8*)(sp + 16 * s + 8 * hh); const bf16x8 bq = *(const bf16x8*)(Crow + (lblk * 32 + r32) * 72 + 16 * s + 8 * hh); t = MFMA32(a, bq, t); }
#pragma unroll
                for (int r = 0; r < 16; ++r) y[hi2][pb][r] += t[r] * ea; asm volatile("" ::: "memory"); } }
        bf16_t* prow = P + (row0 + lblk * 32 + r32) * LDP;
        float sq = 0.f;
#pragma unroll
        for (int hi2 = 0; hi2 < 2; ++hi2)
#pragma unroll
            for (int pb = 0; pb < 2; ++pb)
#pragma unroll
                for (int q = 0; q < 4; ++q) { const int chl = g * 256 + (2 * hp + hi2) * 64 + pb * 32 + 8 * q + 4 * hh; const u32x2 zw = *(const u32x2*)(prow + C_SZ + chl);
                    y[hi2][pb][4 * q] *= siluf_(bf2f(zw.x & 0xffffu)); y[hi2][pb][4 * q + 1] *= siluf_(bf2f(zw.x >> 16)); y[hi2][pb][4 * q + 2] *= siluf_(bf2f(zw.y & 0xffffu)); y[hi2][pb][4 * q + 3] *= siluf_(bf2f(zw.y >> 16));
#pragma unroll
                    for (int e = 0; e < 4; ++e) sq += y[hi2][pb][4 * q + e] * y[hi2][pb][4 * q + e]; if (q & 1) asm volatile("" ::: "memory"); }
        sq += __shfl_xor(sq, 32);
        if (hh == 0) ssq[(lblk * 32 + r32) * 2 + hp] = sq;
        __syncthreads();
        const float rstd = rsqrtf((ssq[(lblk * 32 + r32) * 2] + ssq[(lblk * 32 + r32) * 2 + 1]) * (1.f / 256.f) + EPS);
#pragma unroll
        for (int hi2 = 0; hi2 < 2; ++hi2)
#pragma unroll
            for (int pb = 0; pb < 2; ++pb)
#pragma unroll
                for (int q = 0; q < 4; ++q) { const int chl = g * 256 + (2 * hp + hi2) * 64 + pb * 32 + 8 * q + 4 * hh; const f32x4 ng = *(const f32x4*)(ngain + chl);
                    u32x2 w; w.x = pk2(y[hi2][pb][4 * q] * rstd * ng.x, y[hi2][pb][4 * q + 1] * rstd * ng.y); w.y = pk2(y[hi2][pb][4 * q + 2] * rstd * ng.z, y[hi2][pb][4 * q + 3] * rstd * ng.w);
                    *(u32x2*)(yo + (row0 + lblk * 32 + r32) * ypitch + chl) = w; if (q & 1) asm volatile("" ::: "memory"); }
        __syncthreads();
    }
}

constexpr int AT_KB = 26624, AT_VB = 17408, AT_VOFF = 2 * AT_KB, AT_VP = 132;
__device__ __forceinline__ void attn_pv(f32x16& o0, f32x16& o1, const bf16x8 (&pp)[8], const bf16_t* Vs, int r32, int hh) {
#pragma unroll
    for (int s = 0; s < 8; ++s) { const unsigned char* v0 = (const unsigned char*)(Vs + r32 * AT_VP + 16 * s + 4 * hh); const unsigned char* v1 = (const unsigned char*)(Vs + (32 + r32) * AT_VP + 16 * s + 4 * hh);
        o0 = MFMA32(ld2x64(v0, v0 + 16), pp[s], o0); o1 = MFMA32(ld2x64(v1, v1 + 16), pp[s], o1); }
}
__device__ __forceinline__ void attn_unit(int tid, unsigned char* lds, int b, int h, int qb, const bf16_t* Q, const bf16_t* KN, const bf16_t* KRP, const bf16_t* VT, bf16_t* P) {
    const int lane = tid & 63, wid = tid >> 6, r32 = lane & 31, hh = lane >> 5;
    const bool grpB = false;
    const size_t rowb = (size_t)b * SEQ; const int q0 = qb * 256, qw0 = q0 + wid * 32;
    bf16x8 qf[6];
    { const bf16_t* qp = Q + (rowb + qw0 + r32) * 768 + h * 96 + 8 * hh;
#pragma unroll
      for (int s = 0; s < 6; ++s) qf[s] = *(const bf16x8*)(qp + 16 * s); }
    const int NT = (q0 + 256) / 128, ntw = (qw0 + 31) / 128 + 1;
    const bf16_t* kp = KN + (rowb + (tid >> 3)) * 512 + h * 64 + (tid & 7) * 8;
    const bf16_t* rp = KRP + (rowb + (tid >> 2)) * 32 + (tid & 3) * 8;
    const bf16_t* vp = VT + ((size_t)((b * 8 + h) * 64 + (tid >> 3))) * SEQ + (tid & 7) * 8;
    u32x4 k0r, k1r, rr, v0r, v1r;
#define AT_LD(tt) do { k0r = *(const u32x4*)(kp + (size_t)(tt) * 128 * 512); k1r = *(const u32x4*)(kp + ((size_t)(tt) * 128 + 64) * 512); rr = *(const u32x4*)(rp + (size_t)(tt) * 128 * 32); \
        v0r = *(const u32x4*)(vp + (tt) * 128); v1r = *(const u32x4*)(vp + (tt) * 128 + 64); } while (0)
#define AT_ST(kb, vb) do { bf16_t* Kw = (bf16_t*)(lds + AT_KB * (kb)); bf16_t* Vw = (bf16_t*)(lds + AT_VOFF + AT_VB * (vb)); \
        *(u32x4*)(Kw + (tid >> 3) * 104 + (tid & 7) * 8) = k0r; *(u32x4*)(Kw + (64 + (tid >> 3)) * 104 + (tid & 7) * 8) = k1r; *(u32x4*)(Kw + (tid >> 2) * 104 + 64 + (tid & 3) * 8) = rr; \
        bf16_t* vr = Vw + (tid >> 3) * AT_VP + (tid & 7) * 8; *(u32x2*)vr = (u32x2){v0r.x, v0r.y}; *(u32x2*)(vr + 4) = (u32x2){v0r.z, v0r.w}; *(u32x2*)(vr + 64) = (u32x2){v1r.x, v1r.y}; *(u32x2*)(vr + 68) = (u32x2){v1r.z, v1r.w}; } while (0)
    AT_LD(0);
    float mrun = -INFINITY, lrun = 0.f; f32x16 o0 = {}, o1 = {};
    const int qpos = qw0 + r32;
    bf16x8 pp[8] = {};
    AT_ST(0, 0);
    int vcur = 0, vprev = 2;
    if (NT > 1) AT_LD(1);
    __syncthreads();
    for (int t = 0; t < NT; ++t) {
        const int vnext = (vcur == 2) ? 0 : vcur + 1;
        if (t + 1 < NT) AT_ST((t + 1) & 1, vnext);
        if (t + 2 < NT) AT_LD(t + 2);
        const bf16_t* Ks = (const bf16_t*)(lds + AT_KB * (t & 1)); const bf16_t* Vs = (const bf16_t*)(lds + AT_VOFF + AT_VB * vcur);
        if (grpB && t > 0 && t - 1 < ntw) attn_pv(o0, o1, pp, (const bf16_t*)(lds + AT_VOFF + AT_VB * vprev), r32, hh);
        if (t < ntw) {
            f32x16 p[4] = {};
#pragma unroll
            for (int s = 0; s < 6; ++s)
#pragma unroll
                for (int blk = 0; blk < 4; ++blk) { const bf16x8 a = *(const bf16x8*)(Ks + (32 * blk + r32) * 104 + 16 * s + 8 * hh); p[blk] = MFMA32(a, qf[s], p[blk]); }
            if (t * 128 + 127 > qw0) {
#pragma unroll
                for (int blk = 0; blk < 4; ++blk)
#pragma unroll
                    for (int r = 0; r < 16; ++r) { const int kv = t * 128 + 32 * blk + crow(r, hh); if (kv > qpos) p[blk][r] = -INFINITY; } }
            float rm0 = fmaxf(fmaxf(p[0][0], p[1][0]), fmaxf(p[2][0], p[3][0])), rm1 = fmaxf(fmaxf(p[0][1], p[1][1]), fmaxf(p[2][1], p[3][1]));
            float rm2 = fmaxf(fmaxf(p[0][2], p[1][2]), fmaxf(p[2][2], p[3][2])), rm3 = fmaxf(fmaxf(p[0][3], p[1][3]), fmaxf(p[2][3], p[3][3]));
#pragma unroll
            for (int r = 4; r < 16; r += 4) {
                rm0 = fmaxf(rm0, fmaxf(fmaxf(p[0][r], p[1][r]), fmaxf(p[2][r], p[3][r]))); rm1 = fmaxf(rm1, fmaxf(fmaxf(p[0][r + 1], p[1][r + 1]), fmaxf(p[2][r + 1], p[3][r + 1])));
                rm2 = fmaxf(rm2, fmaxf(fmaxf(p[0][r + 2], p[1][r + 2]), fmaxf(p[2][r + 2], p[3][r + 2]))); rm3 = fmaxf(rm3, fmaxf(fmaxf(p[0][r + 3], p[1][r + 3]), fmaxf(p[2][r + 3], p[3][r + 3]))); }
            float rm = fmaxf(fmaxf(rm0, rm1), fmaxf(rm2, rm3));
            rm = fmaxf(rm, __shfl_xor(rm, 32));
            const float mnew = fmaxf(mrun, rm);
            if (__any(mnew > mrun)) {
                const float alpha = __builtin_amdgcn_exp2f(mrun - mnew); lrun *= alpha;
#pragma unroll
                for (int r = 0; r < 16; ++r) { o0[r] *= alpha; o1[r] *= alpha; } }
            mrun = mnew;
            float ps0 = 0.f, ps1 = 0.f, ps2 = 0.f, ps3 = 0.f;
#pragma unroll
            for (int blk = 0; blk < 4; ++blk) {
#pragma unroll
                for (int r = 0; r < 16; r += 4) {
                    p[blk][r] = __builtin_amdgcn_exp2f(p[blk][r] - mnew); ps0 += p[blk][r]; p[blk][r + 1] = __builtin_amdgcn_exp2f(p[blk][r + 1] - mnew); ps1 += p[blk][r + 1];
                    p[blk][r + 2] = __builtin_amdgcn_exp2f(p[blk][r + 2] - mnew); ps2 += p[blk][r + 2]; p[blk][r + 3] = __builtin_amdgcn_exp2f(p[blk][r + 3] - mnew); ps3 += p[blk][r + 3]; }
                pp[2 * blk] = pack8(p[blk], 0); pp[2 * blk + 1] = pack8(p[blk], 1); }
            lrun += (ps0 + ps1) + (ps2 + ps3);
            if (!grpB) attn_pv(o0, o1, pp, Vs, r32, hh);
        }
        __syncthreads();
        vprev = vcur; vcur = vnext;
    }
#undef AT_LD
#undef AT_ST
    if (grpB && NT - 1 < ntw) attn_pv(o0, o1, pp, (const bf16_t*)(lds + AT_VOFF + AT_VB * vprev), r32, hh);
    lrun += __shfl_xor(lrun, 32);
    const float il = 1.f / lrun;
    bf16_t* orow = P + (rowb + qpos) * LDP + C_YB + h * 64;
#pragma unroll
    for (int q = 0; q < 4; ++q) { u32x2 w0, w1; w0.x = pk2(o0[4 * q] * il, o0[4 * q + 1] * il); w0.y = pk2(o0[4 * q + 2] * il, o0[4 * q + 3] * il); w1.x = pk2(o1[4 * q] * il, o1[4 * q + 1] * il); w1.y = pk2(o1[4 * q + 2] * il, o1[4 * q + 3] * il);
        *(u32x2*)(orow + 8 * q + 4 * hh) = w0; *(u32x2*)(orow + 32 + 8 * q + 4 * hh) = w1; }
    __syncthreads();
}
__device__ __forceinline__ void phase_attn(int wid0, int bid, unsigned char* lds, const bf16_t* Q, const bf16_t* KN, const bf16_t* KRP, const bf16_t* VT, bf16_t* P, int G) {
    const int tid = mk_tid(wid0);
    if (G == 256) { const int bx = bid, vcu = (bx % 8) * 32 + bx / 8, bh = vcu >> 2, s = vcu & 3;
        for (int i = 0; i < 4; ++i) { const int qb = (i == 0) ? 15 - s : (i == 1) ? s : (i == 2) ? 8 + s : 7 - s; attn_unit(tid, lds, bh >> 3, bh & 7, qb, Q, KN, KRP, VT, P); } }
    else for (int u = bid; u < 1024; u += G) attn_unit(tid, lds, u >> 7, (u >> 4) & 7, 15 - (u & 15), Q, KN, KRP, VT, P);
}

#define XB_TMO      128
#define XB_XCNT(j)  (256  + 64 * (j))
#define XB_XSUB(j)  (1280 + 64 * (j))
#define XB_XGEN(j)  (2304 + 64 * (j))
#define XB_TOP      3328
#define XB_TOPGEN   3392
#define XCD_BAR_WORDS 3456
#define XB_SPIN_CAP (1u << 20)
__device__ __forceinline__ unsigned xb_ld(unsigned* p)              { return __hip_atomic_load(p, __ATOMIC_RELAXED, __HIP_MEMORY_SCOPE_AGENT); }
__device__ __forceinline__ unsigned xb_add(unsigned* p, unsigned v) { return __hip_atomic_fetch_add(p, v, __ATOMIC_RELAXED, __HIP_MEMORY_SCOPE_AGENT); }
__device__ __forceinline__ unsigned xb_xcc_id() { return (unsigned)__builtin_amdgcn_s_getreg((3 << 11) | 20) & 0xFu; }
#define XB_SPIN(cond, bar) do { unsigned _sp = 0; while (cond) { __builtin_amdgcn_s_sleep(1); \
    if ((++_sp & 255u) == 0u) { if (xb_ld(&(bar)[XB_TMO])) break; if (_sp > XB_SPIN_CAP) { atomicAdd(&(bar)[XB_TMO], 1u); break; } } } } while (0)
__device__ __forceinline__ void xcd_barrier_complete(unsigned* bar, unsigned x, unsigned G, unsigned& nloc, unsigned& nx) {
    unsigned sum, cnt, mine, sp = 0u;
    for (;;) {
        sum = 0u; cnt = 0u; mine = 0u;
#pragma unroll
        for (unsigned j = 0; j < 16; ++j) { const unsigned c = xb_ld(&bar[XB_XCNT(j)]); sum += c; cnt += (c > 0u) ? 1u : 0u; mine = (j == x) ? c : mine; }
        if (sum == G) break;
        __builtin_amdgcn_s_sleep(1);
        if ((++sp & 255u) == 0u) { if (xb_ld(&bar[XB_TMO])) break; if (sp > XB_SPIN_CAP) { atomicAdd(&bar[XB_TMO], 1u); break; } }
    }
    nloc = mine > 0u ? mine : 1u; nx = cnt > 0u ? cnt : 1u;
}
__device__ __forceinline__ void xcd_barrier(unsigned* bar, volatile LAS unsigned* st, bool leader_thread, unsigned G) {
    asm volatile("s_waitcnt vmcnt(0)" ::: "memory");
    __syncthreads();
    if (leader_thread) {
        const unsigned x = xb_xcc_id();
        __builtin_amdgcn_s_waitcnt(0);
        unsigned nloc = st[0], nx = st[1];
        if (nloc == 0u) { xcd_barrier_complete(bar, x, G, nloc, nx); st[0] = nloc; st[1] = nx; }
        const unsigned old = xb_add(&bar[XB_XSUB(x)], 1u);
        const unsigned gen = old / nloc;
        if (old + 1u == (gen + 1u) * nloc) {
            __builtin_amdgcn_fence(__ATOMIC_RELEASE, "agent");
            asm volatile("s_waitcnt vmcnt(0)" ::: "memory");
            const unsigned og = xb_add(&bar[XB_TOP], 1u);
            const unsigned tg = og / nx;
            if (og + 1u == (tg + 1u) * nx) xb_add(&bar[XB_TOPGEN], 1u);
            else XB_SPIN(xb_ld(&bar[XB_TOPGEN]) == tg, bar);
            __builtin_amdgcn_fence(__ATOMIC_ACQUIRE, "agent");
            xb_add(&bar[XB_XGEN(x)], 1u);
            asm volatile("s_waitcnt vmcnt(0)" ::: "memory");
        } else {
            XB_SPIN(xb_ld(&bar[XB_XGEN(x)]) == gen, bar);
            __builtin_amdgcn_fence(__ATOMIC_ACQUIRE, "agent");
            asm volatile("s_waitcnt vmcnt(0)" ::: "memory");
        }
    }
    __syncthreads();
}
#ifndef DUP_SEQ
#define DUP_SEQ 0
#endif
#if DUP_SEQ == 1
constexpr int PH_PER_LAYER = 22;
__host__ __device__ __forceinline__ int step_k(int s, int& flag) { flag = (s == 4); return s < 4 ? s : (s < 6 ? s - 2 : s - 2); }
#elif DUP_SEQ == 2
constexpr int PH_PER_LAYER = 22;
__host__ __device__ __forceinline__ int step_k(int s, int& flag) { flag = (s == 4 || s == 5); return s < 4 ? s : s - 2; }
#else
constexpr int PH_PER_LAYER = 20;
__host__ __device__ __forceinline__ int step_k(int s, int& flag) { flag = 0; return s; }
#endif
__host__ __device__ __forceinline__ bool k_nosync(int k) { return k == 5 || k == 7 || k == 8 || (k >= 11 && k <= 15) || k == 17; }
constexpr int LDS_BYTES = 147456, PH_TOTAL = DEPTH * PH_PER_LAYER + 1;
__global__ void __launch_bounds__(512, 2) fwd_mega(Args Aarg) {
    extern __shared__ __attribute__((aligned(16))) unsigned char lds[];
    cg::grid_group grid = cg::this_grid();
    const int G = gridDim.x;
    LAS unsigned char* ldsl = (LAS unsigned char*)lds;
    const int ph_lo = Aarg.ph_lo, ph_hi = Aarg.ph_hi;
    if (ph_lo < 0) grid.sync();
    const int wid0 = __builtin_amdgcn_readfirstlane((int)(threadIdx.x >> 6));
    if (threadIdx.x < 2) ((volatile LAS unsigned*)(ldsl + 133120))[threadIdx.x] = 0u;
    __syncthreads();
    if (threadIdx.x == 0) (void)xb_add((unsigned*)Aarg.ws + XB_XCNT(xb_xcc_id()), 1u);
    for (int ph = ph_lo; ph < ph_hi; ++ph) {
        int bid = blockIdx.x; asm volatile("" : "+s"(bid));
        AP A = (AP)__builtin_amdgcn_kernarg_segment_ptr(); asm volatile("" : "+s"(A));
        int flag; const int k = step_k(ph % PH_PER_LAYER, flag);
        { const bool nosync = (ph != PH_TOTAL - 1) && k_nosync(k);
#ifdef EXTRA_BAR
          for (int xb = 0; xb < ((ph > ph_lo && !nosync) ? 1 + EXTRA_BAR : 0); ++xb) {
#else
          if (ph > ph_lo && !nosync) {
#endif
              xcd_barrier((unsigned*)A->ws, (volatile LAS unsigned*)(ldsl + 133120), mk_tid(wid0) == 0, (unsigned)G); } }
        unsigned char* ws = A->ws; float* out = A->out;
        bf16_t* H = (bf16_t*)(ws + WS_H); bf16_t* P = (bf16_t*)(ws + WS_P);
        const int l = ph / PH_PER_LAYER;
        if (ph == PH_TOTAL - 1) { const int tid = mk_tid(wid0); const int lane = tid & 63, gw = bid * 8 + (tid >> 6);
            const f32x4* gr = (const f32x4*)A->in[23] + lane;
            for (int m0 = gw * 2; m0 < MTOK; m0 += G * 16) {
                u32x2 w[2][4]; float sq[2];
#pragma unroll
                for (int i = 0; i < 2; ++i) { const u32x2* xr = (const u32x2*)(H + (size_t)(m0 + i) * DM) + lane;
#pragma unroll
                    for (int j = 0; j < 4; ++j) w[i][j] = xr[64 * j]; }
#pragma unroll
                for (int i = 0; i < 2; ++i) { float s = 0.f;
#pragma unroll
                    for (int j = 0; j < 4; ++j) { const float a = bf2f(w[i][j].x & 0xffffu), b = bf2f(w[i][j].x >> 16), c = bf2f(w[i][j].y & 0xffffu), d = bf2f(w[i][j].y >> 16); s += (a * a + b * b) + (c * c + d * d); }
                    sq[i] = rsqrtf(wave_sum(s) * (1.f / DM) + EPS); }
#pragma unroll
                for (int i = 0; i < 2; ++i) { f32x4* xr = (f32x4*)(out + (size_t)(m0 + i) * DM) + lane;
#pragma unroll
                    for (int j = 0; j < 4; ++j) { const f32x4 g4 = gr[64 * j]; f32x4 o; o.x = bf2f(w[i][j].x & 0xffffu) * sq[i] * g4.x; o.y = bf2f(w[i][j].x >> 16) * sq[i] * g4.y; o.z = bf2f(w[i][j].y & 0xffffu) * sq[i] * g4.z; o.w = bf2f(w[i][j].y >> 16) * sq[i] * g4.w; xr[64 * j] = o; } } }
            continue; }
        const float* xin = (l == 0) ? A->in[0] : out;
        pg8::StaticOrder S;
#ifdef DUP_K
        for (int rep = 0; rep < ((k == DUP_K || k == DUP_K2) ? 2 : 1); ++rep)
#endif
        switch (k) {
        case 0: phase_weights(wid0, bid, A, l, lds, G); if (l == 0) phase_xcast(wid0, bid, xin, H, (float*)(ws + WS_SSQA), G); break;
        case 1: { pg8::Gemm g{H, (const bf16_t*)(ws + WS_WIN), MTOK, 4096, DM, DM}; S.init(MTOK, 4096, G, bid);
            pg8::EpiBf16<0, 0> E{P, LDP, nullptr, 0, (const float*)(ws + WS_SSQA)}; pg8::gemm_phase(wid0, ldsl, g, S, E); } break;
        case 2: if (!flag) phase_elem(wid0, bid, P, A->in[6] + l * 384, A->in[7] + l * 256, (const float*)(ws + WS_ROPE), (bf16_t*)(ws + WS_KRP), G);
            hgrn_pass1(wid0, bid, lds, P, (const float*)(ws + WS_LBS) + l * 512, (bf16_t*)(ws + WS_HST), (float*)(ws + WS_HGD), G);
            mamba_pass1(wid0, bid, lds, P, A->in[10] + l * 4 * 768, A->in[11] + l * 768, A->in[12] + l * 8, A->in[13] + l * 8, (bf16_t*)(ws + WS_MST), (float*)(ws + WS_MAT), G); break;
        case 3: hgrn_scan(wid0, bid, (bf16_t*)(ws + WS_HST), (const float*)(ws + WS_HGD), G); mamba_scan(wid0, bid, (bf16_t*)(ws + WS_MST), (const float*)(ws + WS_MAT), G); break;
        case 4: hgrn_pass3(wid0, bid, lds, flag ? (bf16_t*)(ws + WS_VT) : P + C_YA, flag ? 512 : LDP, P, (const float*)(ws + WS_LBS) + l * 512, A->in[5] + l * 512, (const bf16_t*)(ws + WS_HST), G); break;
        case 5: mamba_pass3(wid0, bid, lds, flag ? (bf16_t*)(ws + WS_VT) : P + C_YC, flag ? 512 : LDP, P, A->in[10] + l * 4 * 768, A->in[11] + l * 768, A->in[12] + l * 8, A->in[13] + l * 8, A->in[14] + l * 8, A->in[15] + l * 512, (const bf16_t*)(ws + WS_MST), G); break;
        case 6: { pg8::Gemm g{P + C_CQ, (const bf16_t*)(ws + WS_WUQ), MTOK, 768, 384, LDP}; S.init(MTOK, 768, G, bid);
                    pg8::EpiQ E{(bf16_t*)(ws + WS_Q), (const float*)(ws + WS_ROPE)}; pg8::gemm_phase(wid0, ldsl, g, S, E); } break;
        case 7: { pg8::Gemm g{P + C_CKV, (const bf16_t*)(ws + WS_WUK), MTOK, 512, 256, LDP}; S.init(MTOK, 512, G, bid);
                    pg8::EpiBf16<0, 0> E{(bf16_t*)(ws + WS_KN), 512, nullptr, 0, nullptr}; pg8::gemm_phase(wid0, ldsl, g, S, E); } break;
        case 8: { pg8::Gemm g{P + C_CKV, (const bf16_t*)(ws + WS_WUV), MTOK, 512, 256, LDP}; S.init(MTOK, 512, G, bid);
                    pg8::EpiVT E{(bf16_t*)(ws + WS_VT)}; pg8::gemm_phase(wid0, ldsl, g, S, E); } break;
        case 9: phase_attn(wid0, bid, lds, (const bf16_t*)(ws + WS_Q), (const bf16_t*)(ws + WS_KN), (const bf16_t*)(ws + WS_KRP), (const bf16_t*)(ws + WS_VT), P, G); break;
        case 10: { S.init(MTOK, DM, G, bid);
            pg8::MergeArgs ma{H, P, (const bf16_t*)(ws + WS_WIN) + (size_t)4096 * DM, (const bf16_t*)(ws + WS_WBR)};
            pg8::EpiBf16<2, 0> EG{(bf16_t*)(ws + WS_G), DM, nullptr, 0, (const float*)(ws + WS_SSQA)};
            pg8::EpiBf16<0, 1> EB1{(bf16_t*)(ws + WS_MG), DM, (const bf16_t*)(ws + WS_G), DM, nullptr};
            pg8::EpiBf16<0, 2> EB2{(bf16_t*)(ws + WS_MG), DM, (const bf16_t*)(ws + WS_G), DM, nullptr};
            pg8::gemm_merge(wid0, ldsl, ma, S, EG, EB1, EB2); } break;
        case 11: case 12: case 13: case 14: case 15: break;
        case 16: { pg8::Gemm g{(const bf16_t*)(ws + WS_MG), (const bf16_t*)(ws + WS_WOUT), MTOK, DM, DM, DM}; S.init(MTOK, DM, G, bid);
            pg8::EpiRes E{H, (float*)(ws + WS_SSQB)}; pg8::gemm_phase(wid0, ldsl, g, S, E); } break;
        case 17: break;
        case 18: { pg8::Gemm g{H, (const bf16_t*)(ws + WS_WUP), MTOK, DFF, DM, DM}; S.init(MTOK, DFF, G, bid);
            pg8::EpiBf16<1, 0> E{P, DFF, nullptr, 0, (const float*)(ws + WS_SSQB)}; pg8::gemm_phase(wid0, ldsl, g, S, E); } break;
        case 19: { pg8::Gemm g{P, (const bf16_t*)(ws + WS_WDN), MTOK, DM, DFF, DFF}; S.init(MTOK, DM, G, bid);
            pg8::EpiRes E{H, (float*)(ws + WS_SSQA)}; pg8::gemm_phase(wid0, ldsl, g, S, E); } break;
        }
    }
}

#ifdef DBG_STOP
__global__ void dbg_dump(const unsigned char* ws, float* out) {
    const bf16_t* B0 = (const bf16_t*)(ws + DBG_B0); const bf16_t* B1 = (const bf16_t*)(ws + DBG_B1);
    for (size_t e = (size_t)blockIdx.x * 256 + threadIdx.x; e < (size_t)MTOK * DM; e += (size_t)gridDim.x * 256) { const size_t m = e >> 10; const int c = (int)(e & 1023);
        out[e] = c < 512 ? bf2f(B0[m * DBG_P0 + c]) : bf2f(B1[m * DBG_P1 + (c - 512)]); }
}
#endif
extern "C" void kernel_launch(void* const* d_in, const int* in_sizes, int n_in, void* d_out, int out_size, void* d_ws, size_t ws_size, hipStream_t stream) {
    static int grid = 0;
    if (grid == 0) {
        if (n_in != 24 || out_size != MTOK * DM || ws_size < WS_END) { fprintf(stderr, "kernel_launch: unexpected shapes (n_in %d out %d ws %zu)\n", n_in, out_size, ws_size); grid = -1; return; }
        int dev = 0, cus = 0, per_cu = 0;
        hipGetDevice(&dev); hipDeviceGetAttribute(&cus, hipDeviceAttributeMultiprocessorCount, dev);
        hipFuncSetAttribute((const void*)fwd_mega, hipFuncAttributeMaxDynamicSharedMemorySize, LDS_BYTES);
        hipOccupancyMaxActiveBlocksPerMultiprocessor(&per_cu, (const void*)fwd_mega, 512, LDS_BYTES);
        (void)hipGetLastError();
        grid = (per_cu >= 1) ? cus : -1;
        if (grid < 0) { fprintf(stderr, "kernel_launch: occupancy query says 0 blocks/CU\n"); return; }
    }
    if (grid < 0) return;
    if (hipMemsetAsync(d_ws, 0, 16384, stream) != hipSuccess) { fprintf(stderr, "memset failed\n"); return; }
    Args a{};
    for (int i = 0; i < 24; ++i) a.in[i] = (const float*)d_in[i];
    a.out = (float*)d_out; a.ws = (unsigned char*)d_ws; a.ph_lo = 0; a.ph_hi = PH_TOTAL;
#ifndef MULTI_LAUNCH
#define MULTI_LAUNCH 0
#endif
#if MULTI_LAUNCH
#ifdef DBG_STOP
    const int PH_END = DBG_STOP;
#else
    const int PH_END = PH_TOTAL;
#endif
    for (int lo = 0; lo < PH_END; ) {
        int hi = lo + 1;

        while (hi < PH_TOTAL - 1) { int fl; if (k_nosync(step_k(hi % PH_PER_LAYER, fl))) ++hi; else break; }
        a.ph_lo = lo; a.ph_hi = hi;
        hipLaunchKernelGGL(fwd_mega, dim3(grid), dim3(512), LDS_BYTES, stream, a);
        lo = hi;
    }
#ifdef DBG_STOP
    hipLaunchKernelGGL(dbg_dump, dim3(2048), dim3(256), 0, stream, (const unsigned char*)d_ws, (float*)d_out);
#endif
#else
    void* args[] = {&a};
    hipError_t e = hipLaunchCooperativeKernel((const void*)fwd_mega, dim3(grid), dim3(512), args, LDS_BYTES, stream);
    if (e != hipSuccess) fprintf(stderr, "cooperative launch failed: %s (grid %d)\n", hipGetErrorString(e), grid);
#endif
}
```

```cpp
#include <hip/hip_runtime.h>
#include <hip/hip_cooperative_groups.h>
#include <cstdio>
#include <cstdint>
namespace cg = cooperative_groups;

typedef unsigned short bf16_t;
typedef short bf16x8 __attribute__((ext_vector_type(8)));
typedef short s16x4 __attribute__((ext_vector_type(4)));
typedef float f32x4 __attribute__((ext_vector_type(4)));
typedef float f32x16 __attribute__((ext_vector_type(16)));
typedef unsigned u32x4 __attribute__((ext_vector_type(4)));
typedef unsigned u32x2 __attribute__((ext_vector_type(2)));
#define LAS __attribute__((address_space(3)))

constexpr int DM = 1024, NB = 8, SEQ = 4096, DEPTH = 4, MTOK = NB * SEQ;
constexpr int LDP = 4096;
constexpr int C_HQ = 0, C_HF = 512, C_HI = 1024, C_HG = 1536, C_CQ = 2048, C_CKV = 2432, C_KR = 2688, C_SZ = 2720, C_XBC = 3232, C_DT = 4000;
constexpr int C_YA = C_HQ, C_YB = C_CQ, C_YC = C_SZ;
constexpr int IN_COLS = 7080, NPROJ = 4008, DFF = 4096;
constexpr float EPS = 1e-6f;
constexpr float QSCALE = 0.10206207261596575f * 1.4426950408889634f;

constexpr size_t MiB = 1u << 20;
constexpr size_t WS_WIN = 1 * MiB;
constexpr size_t WS_WUQ = 15 * MiB;
constexpr size_t WS_WUK = 16 * MiB;
constexpr size_t WS_WUV = WS_WUK + 512 * 256 * 2;
constexpr size_t WS_WBR = 17 * MiB;
constexpr size_t WS_WOUT = 20 * MiB;
constexpr size_t WS_WUP = 22 * MiB;
constexpr size_t WS_WDN = 30 * MiB;
constexpr size_t WS_ROPE = 38 * MiB;
constexpr size_t WS_LBS = 42 * MiB;
constexpr size_t WS_HGD = 42 * MiB + 65536;
constexpr size_t WS_MAT = 43 * MiB + 131072;
constexpr size_t WS_SSQA = 492 * MiB;
constexpr size_t WS_SSQB = 494 * MiB;
constexpr size_t WS_H = 44 * MiB;
constexpr size_t WS_P = 108 * MiB;
constexpr size_t WS_R = 364 * MiB;
constexpr size_t WS_HST = WS_R;
constexpr size_t WS_MST = WS_R + 64 * MiB;
constexpr size_t WS_Q = WS_R;
constexpr size_t WS_KN = WS_R + 48 * MiB;
constexpr size_t WS_VT = WS_R + 80 * MiB;
constexpr size_t WS_KRP = WS_R + 112 * MiB;
constexpr size_t OB_Q = 0, OB_KN = 48 * MiB, OB_VT = 80 * MiB, OB_KRP = 112 * MiB;
constexpr size_t WS_G = WS_R;
constexpr size_t WS_MG = WS_R + 64 * MiB;
constexpr size_t WS_END = 496 * MiB;

__device__ __forceinline__ float bf2f(unsigned v) { return __uint_as_float(v << 16); }
__device__ __forceinline__ unsigned f2bf(float f) { unsigned u = __float_as_uint(f); return (u + 0x7fffu + ((u >> 16) & 1u)) >> 16; }
__device__ __forceinline__ unsigned pk2(float lo, float hi) { return f2bf(lo) | (f2bf(hi) << 16); }
typedef float f32x2_t __attribute__((ext_vector_type(2))); typedef __bf16 bf16x2_t __attribute__((ext_vector_type(2)));
__device__ __forceinline__ unsigned cvt_pk_bf16(float lo, float hi) { f32x2_t v = {lo, hi}; bf16x2_t b = __builtin_convertvector(v, bf16x2_t); return __builtin_bit_cast(unsigned, b); }
__device__ __forceinline__ float sigmoidf_(float x) { return __builtin_amdgcn_rcpf(1.f + __expf(-x)); }
__device__ __forceinline__ float siluf_(float x) { return x * sigmoidf_(x); }
__device__ __forceinline__ int crow(int r, int h) { return (r & 3) + 8 * (r >> 2) + 4 * h; }
__device__ __forceinline__ float wave_sum(float v) {
#pragma unroll
    for (int o = 1; o < 64; o <<= 1) v += __shfl_xor(v, o);
    return v;
}
__device__ __forceinline__ int mk_tid(int wid0) { int l; asm volatile("v_mbcnt_lo_u32_b32 %0, -1, 0\n\tv_mbcnt_hi_u32_b32 %0, -1, %0" : "=v"(l)); return l + wid0 * 64; }
#define MFMA32(a, b, c) __builtin_amdgcn_mfma_f32_32x32x16_bf16((a), (b), (c), 0, 0, 0)
__device__ __forceinline__ bf16x8 pack8(const f32x16& c, int s) {
    u32x4 w; w.x = cvt_pk_bf16(c[8 * s + 0], c[8 * s + 1]); w.y = cvt_pk_bf16(c[8 * s + 2], c[8 * s + 3]);
    w.z = cvt_pk_bf16(c[8 * s + 4], c[8 * s + 5]); w.w = cvt_pk_bf16(c[8 * s + 6], c[8 * s + 7]); return __builtin_bit_cast(bf16x8, w);
}
__device__ __forceinline__ bf16x8 ld2x64(const unsigned char* p0, const unsigned char* p1) {
    const u32x2 a = *(const u32x2*)p0, b = *(const u32x2*)p1; u32x4 w; w.x = a.x; w.y = a.y; w.z = b.x; w.w = b.y; return __builtin_bit_cast(bf16x8, w);
}

namespace pg8 {
constexpr int BM = 256, BK = 64, HALF = 128, HTB = HALF * BK * 2, STAGE_BYTES = 8 * HTB, NXCD = 8, WGM = 8;
__host__ __device__ __forceinline__ int lds_byte(int r, int c) { const int st = (r >> 4) * 2 + (c >> 5), rr = r & 15, cc = c & 31, ob = rr * 64 + cc * 2; return st * 1024 + (ob ^ (((ob >> 9) & 1) << 5)); }
__host__ __device__ __forceinline__ void stage_rc(int b, int& R, int& C) { const int st = b / 1024, sb = b % 1024, swz = sb ^ (((sb >> 9) & 1) << 5); R = (st >> 1) * 16 + swz / 64; C = (st & 1) * 32 + (swz % 64) / 2; }
__host__ __device__ __forceinline__ int perm32(int rho) { const int n = rho >> 4, i = rho & 15; return 8 * (i >> 2) + 4 * n + (i & 3); }
struct Unit { int pm, pn; };
struct Gemm { const bf16_t* A; const bf16_t* Bt; int M, N, K, lda; };
struct StaticOrder {
    int nM, nN, nwg, G, c;
    __device__ void init(int M, int N, int G_, int c_) { nM = M / BM; nN = N / BM; nwg = nM * nN; G = G_; c = c_; }
    __device__ bool next(int i, Unit& u) const {
        const long L = (long)i * G + c; if (L >= nwg) return false;
        int wgid = (int)L; { const int q = nwg / NXCD, r = nwg % NXCD, xcd = wgid % NXCD, off = wgid / NXCD; wgid = (xcd < r ? xcd * (q + 1) : r * (q + 1) + (xcd - r) * q) + off; }
        const int nig = WGM * nN, gid = wgid / nig, fm = gid * WGM, gsz = (nM - fm) < WGM ? (nM - fm) : WGM;
        u.pm = fm + ((wgid % nig) % gsz); u.pn = (wgid % nig) / gsz; return true;
    }
};
template <class Epi>
__device__ __forceinline__ void gemm_phase(int wid0, LAS unsigned char* lds, const Gemm g, const StaticOrder& S, const Epi& E) {
    const int tid = mk_tid(wid0);
    const int wid = __builtin_amdgcn_readfirstlane(tid >> 6), lane = tid & 63, wr = wid >> 2, wc = wid & 3, fr = lane & 15, fq = lane >> 4;
    int K = g.K; asm volatile("" : "+s"(K));
    const int nt = K / BK, lda = g.lda;
    unsigned voffA_, voffB_;
    { int R, C; stage_rc(tid * 16, R, C); const int Rb = Epi::PERM ? ((R & ~31) + perm32(R & 31)) : R;
      voffA_ = (unsigned)(R * lda + C) * 2u; voffB_ = (unsigned)(Rb * K + C) * 2u; }
    const unsigned voA = voffA_, voB = voffB_;
    const unsigned v2A = 64u * (unsigned)lda * 2u, v2B = 64u * (unsigned)K * 2u;
    const size_t kstep = (size_t)(BK * 2);
    const size_t hstepA = (size_t)HALF * lda * 2, tstepA = 2 * hstepA;
    const size_t hstepB = (size_t)HALF * K * 2, tstepB = 2 * hstepB;
    const unsigned ldsw = (unsigned)wid * 1024u;
    const int aoff = lds_byte(wr * 64 + fr, fq * 8), boff = lds_byte(wc * 32 + fr, fq * 8);
#define PG8_SA(b, h) (((b) * 2 + (h)) * HTB)
#define PG8_SB(b, h) ((4 + (b) * 2 + (h)) * HTB)
#define PG8_STAGE(bufoff, gbase, voff) do { _Pragma("unroll") for (int _i = 0; _i < 2; ++_i) \
        __builtin_amdgcn_global_load_lds((const unsigned*)((const char*)(gbase) + (size_t)(_i * v2##voff) + vo##voff), (LAS unsigned*)(lds + (bufoff) + ldsw + _i * 8192), 16, 0, 0); } while (0)
#define PG8_LDA(dst, b, h) do { _Pragma("unroll") for (int m = 0; m < 4; ++m) _Pragma("unroll") for (int k = 0; k < 2; ++k) dst[m][k] = *(const LAS bf16x8*)(lds + PG8_SA(b, h) + aoff + m * 2048 + k * 1024); } while (0)
#define PG8_LDB(dst, b, h) do { _Pragma("unroll") for (int n = 0; n < 2; ++n) _Pragma("unroll") for (int k = 0; k < 2; ++k) dst[n][k] = *(const LAS bf16x8*)(lds + PG8_SB(b, h) + boff + n * 2048 + k * 1024); } while (0)
#define PG8_MMA(ai, bj, At, Bt) do { __builtin_amdgcn_s_setprio(1); _Pragma("unroll") for (int m = 0; m < 4; ++m) _Pragma("unroll") for (int n = 0; n < 2; ++n) _Pragma("unroll") for (int k = 0; k < 2; ++k) \
        acc[ai][bj][m][n] = Epi::SWAP ? __builtin_amdgcn_mfma_f32_16x16x32_bf16(Bt[n][k], At[m][k], acc[ai][bj][m][n], 0, 0, 0) \
                                      : __builtin_amdgcn_mfma_f32_16x16x32_bf16(At[m][k], Bt[n][k], acc[ai][bj][m][n], 0, 0, 0); __builtin_amdgcn_s_setprio(0); } while (0)
#define PG8_WAIT_V(n) asm volatile("s_waitcnt vmcnt(" #n ")" ::: "memory")
#define PG8_WAIT_L(n) asm volatile("s_waitcnt lgkmcnt(" #n ")" ::: "memory")
#define PG8_BAR __builtin_amdgcn_s_barrier()
#define PG8_SCHED __builtin_amdgcn_sched_barrier(0)
    Unit cur, nxt; int ui = 0;
    if (!S.next(0, cur)) return;
    f32x4 acc[2][2][4][2];
#pragma unroll
    for (int a = 0; a < 2; ++a)
#pragma unroll
        for (int b = 0; b < 2; ++b)
#pragma unroll
            for (int m = 0; m < 4; ++m)
#pragma unroll
                for (int n = 0; n < 2; ++n) acc[a][b][m][n] = (f32x4){0.f, 0.f, 0.f, 0.f};
    bf16x8 At[4][2], B0[2][2], B1[2][2];
    const char* cA = (const char*)g.A + (size_t)cur.pm * tstepA; const char* cB = (const char*)g.Bt + (size_t)cur.pn * tstepB;
    LAS float* const tab0 = (LAS float*)(lds + STAGE_BYTES);
    if constexpr (Epi::HAS_PRE) E.pre(tab0, cur, tid);
    PG8_STAGE(PG8_SB(0, 0), cB, B); PG8_STAGE(PG8_SB(0, 1), cB + hstepB, B); PG8_STAGE(PG8_SA(0, 0), cA, A); PG8_STAGE(PG8_SA(0, 1), cA + hstepA, A);
    if (wr == 1) PG8_BAR;
    PG8_WAIT_V(2); PG8_BAR;
    PG8_STAGE(PG8_SB(1, 0), cB + kstep, B); PG8_STAGE(PG8_SA(1, 0), cA + kstep, A); PG8_STAGE(PG8_SB(1, 1), cB + hstepB + kstep, B);
    PG8_WAIT_V(6); PG8_BAR;
    for (;;) {
        const bool has_next = S.next(ui + 1, nxt);
        const char* nA = has_next ? (const char*)g.A + (size_t)nxt.pm * tstepA : cA; const char* nB = has_next ? (const char*)g.Bt + (size_t)nxt.pn * tstepB : cB;
        for (int t = 0; t < nt; t += 2) {
            const bool last = (t == nt - 2);
            const char* a1 = cA + (size_t)(t + 1) * kstep;
            const char* a2 = last ? nA : cA + (size_t)(t + 2) * kstep; const char* b2 = last ? nB : cB + (size_t)(t + 2) * kstep;
            const char* a3 = a2 + kstep; const char* b3 = b2 + kstep;
            PG8_LDB(B0, 0, 0); PG8_LDB(B1, 0, 1); PG8_SCHED; PG8_LDA(At, 0, 0); PG8_STAGE(PG8_SA(1, 1), a1 + hstepA, A);
            PG8_WAIT_V(8); PG8_WAIT_L(0); PG8_BAR; PG8_MMA(0, 0, At, B0); PG8_MMA(0, 1, At, B1); PG8_BAR; PG8_SCHED;
            PG8_LDA(At, 0, 1); PG8_STAGE(PG8_SB(0, 0), b2, B); PG8_STAGE(PG8_SB(0, 1), b2 + hstepB, B); PG8_STAGE(PG8_SA(0, 0), a2, A);
            PG8_WAIT_V(8); PG8_WAIT_L(0); PG8_BAR; PG8_MMA(1, 0, At, B0); PG8_MMA(1, 1, At, B1); PG8_BAR; PG8_SCHED;
            PG8_LDB(B0, 1, 0); PG8_LDB(B1, 1, 1); PG8_SCHED; PG8_LDA(At, 1, 0); PG8_STAGE(PG8_SA(0, 1), a2 + hstepA, A);
            PG8_WAIT_V(8); PG8_WAIT_L(0); PG8_BAR; PG8_MMA(0, 0, At, B0); PG8_MMA(0, 1, At, B1); PG8_BAR; PG8_SCHED;
            PG8_LDA(At, 1, 1); PG8_STAGE(PG8_SB(1, 0), b3, B); PG8_STAGE(PG8_SB(1, 1), b3 + hstepB, B); PG8_STAGE(PG8_SA(1, 0), a3, A);
            PG8_WAIT_V(8); PG8_WAIT_L(0); PG8_BAR; PG8_MMA(1, 0, At, B0); PG8_MMA(1, 1, At, B1); PG8_BAR; PG8_SCHED;
        }
        if (wr == 0) PG8_BAR;
        { int le; asm volatile("v_mbcnt_lo_u32_b32 %0, -1, 0\n\tv_mbcnt_hi_u32_b32 %0, -1, %0" : "=v"(le));
          E(acc, cur, wr, wc, le & 15, le >> 4, tab0 + (ui & 1) * 256); }
        if (!has_next) break;
#pragma unroll
        for (int a = 0; a < 2; ++a)
#pragma unroll
            for (int b = 0; b < 2; ++b)
#pragma unroll
                for (int m = 0; m < 4; ++m)
#pragma unroll
                    for (int n = 0; n < 2; ++n) acc[a][b][m][n] = (f32x4){0.f, 0.f, 0.f, 0.f};
        cur = nxt; cA = nA; cB = nB; ++ui;
        if constexpr (Epi::HAS_PRE) E.pre(tab0 + (ui & 1) * 256, cur, mk_tid(wid0));
        if (wr == 1) PG8_BAR;
    }
    PG8_WAIT_V(0);
    PG8_BAR;
#undef PG8_SA
#undef PG8_SB
#undef PG8_STAGE
#undef PG8_LDA
#undef PG8_LDB
#undef PG8_MMA
#undef PG8_WAIT_V
#undef PG8_WAIT_L
#undef PG8_BAR
#undef PG8_SCHED
}

template <int ACT, int MODE> struct EpiBf16 {
    static constexpr bool PERM = true, SWAP = true, HAS_PRE = true;
    bf16_t* O; int ldc; const bf16_t* Gt; int ldg; const float* ssq;
    __device__ __forceinline__ void pre(LAS float* tab, const Unit& u, int tid) const {
        if (ssq && tid < 256) { const f32x4* sp = (const f32x4*)(ssq + (size_t)(u.pm * BM + tid) * 16); const f32x4 s0 = sp[0], s1 = sp[1], s2 = sp[2], s3 = sp[3];
            tab[tid] = rsqrtf(((((s0[0] + s0[1]) + (s0[2] + s0[3])) + ((s1[0] + s1[1]) + (s1[2] + s1[3]))) + (((s2[0] + s2[1]) + (s2[2] + s2[3])) + ((s3[0] + s3[1]) + (s3[2] + s3[3])))) * (1.f / DM) + EPS); }
    }
    __device__ __forceinline__ void operator()(const f32x4 (&acc)[2][2][4][2], const Unit& u, int wr, int wc, int fr, int fq, const LAS float* tab) const {
        const int row0 = u.pm * BM + wr * 64 + fr, col0 = u.pn * BM + wc * 32 + 8 * fq;
#pragma unroll
        for (int ai = 0; ai < 2; ++ai)
#pragma unroll
            for (int m = 0; m < 4; ++m) { const size_t r = (size_t)(row0 + ai * HALF + m * 16); bf16_t* rowp = O + r * ldc + col0; const float rs = ssq ? tab[ai * HALF + wr * 64 + m * 16 + fr] : 1.f;
#pragma unroll
                for (int bj = 0; bj < 2; ++bj) { f32x4 v0 = acc[ai][bj][m][0], v1 = acc[ai][bj][m][1];
                    float v[8] = {v0[0] * rs, v0[1] * rs, v0[2] * rs, v0[3] * rs, v1[0] * rs, v1[1] * rs, v1[2] * rs, v1[3] * rs};
                    if (ACT == 1) {
#pragma unroll
                        for (int e = 0; e < 8; ++e) { const float t = v[e] > 0.f ? v[e] : 0.f; v[e] = t * t; } }
                    if (ACT == 2) {
#pragma unroll
                        for (int e = 0; e < 8; ++e) v[e] = sigmoidf_(v[e]); }
                    if (MODE >= 1) { const u32x4 gw = *(const u32x4*)(Gt + r * ldg + col0 + bj * HALF);
                        const unsigned gg[4] = {gw.x, gw.y, gw.z, gw.w};
#pragma unroll
                        for (int e = 0; e < 4; ++e) { v[2 * e] *= bf2f(gg[e] & 0xffffu); v[2 * e + 1] *= bf2f(gg[e] >> 16); } }
                    if (MODE == 2) { const u32x4 ow = *(const u32x4*)(rowp + bj * HALF);
                        const unsigned oo[4] = {ow.x, ow.y, ow.z, ow.w};
#pragma unroll
                        for (int e = 0; e < 4; ++e) { v[2 * e] += bf2f(oo[e] & 0xffffu); v[2 * e + 1] += bf2f(oo[e] >> 16); } }
                    u32x4 w; w.x = cvt_pk_bf16(v[0], v[1]); w.y = cvt_pk_bf16(v[2], v[3]); w.z = cvt_pk_bf16(v[4], v[5]); w.w = cvt_pk_bf16(v[6], v[7]);
                    *(u32x4*)(rowp + bj * HALF) = w; } }
    }
};
struct EpiRes {
    static constexpr bool PERM = false, SWAP = true, HAS_PRE = false;
    bf16_t* xb; float* ssq;
    __device__ __forceinline__ void operator()(const f32x4 (&acc)[2][2][4][2], const Unit& u, int wr, int wc, int fr, int fq, const LAS float* tab) const {
        const int col0 = u.pn * BM + wc * 32 + 4 * fq; const int r0 = u.pm * BM + wr * 64 + fr;
        bf16_t* xp = xb + (size_t)r0 * DM + col0;
#pragma unroll
        for (int ai = 0; ai < 2; ++ai) {
            u32x2 bs[4][2][2];
#pragma unroll
            for (int m = 0; m < 4; ++m)
#pragma unroll
                for (int bj = 0; bj < 2; ++bj)
#pragma unroll
                    for (int n = 0; n < 2; ++n) bs[m][bj][n] = *(const u32x2*)(xp + (size_t)(ai * HALF + m * 16) * DM + bj * HALF + n * 16);
            asm volatile("" ::: "memory");
#pragma unroll
            for (int m = 0; m < 4; ++m) { float sq = 0.f;
#pragma unroll
                for (int bj = 0; bj < 2; ++bj)
#pragma unroll
                    for (int n = 0; n < 2; ++n) { const u32x2 bw = bs[m][bj][n]; const f32x4 a = acc[ai][bj][m][n];
                        const float v0 = bf2f(bw.x & 0xffffu) + a[0], v1 = bf2f(bw.x >> 16) + a[1], v2 = bf2f(bw.y & 0xffffu) + a[2], v3 = bf2f(bw.y >> 16) + a[3];
                        sq += (v0 * v0 + v1 * v1) + (v2 * v2 + v3 * v3);
                        u32x2 w; w.x = cvt_pk_bf16(v0, v1); w.y = cvt_pk_bf16(v2, v3); *(u32x2*)(xp + (size_t)(ai * HALF + m * 16) * DM + bj * HALF + n * 16) = w; }
                sq += __shfl_xor(sq, 16); sq += __shfl_xor(sq, 32);
                if (fq == 0) ssq[(size_t)(r0 + ai * HALF + m * 16) * 16 + u.pn * 4 + wc] = sq; }
            asm volatile("" ::: "memory"); }
    }
};
struct EpiQ {
    static constexpr bool PERM = false, SWAP = true, HAS_PRE = false;
    bf16_t* O; const float* rope;
    __device__ __forceinline__ void operator()(const f32x4 (&acc)[2][2][4][2], const Unit& u, int wr, int wc, int fr, int fq, const LAS float* tab) const {
        const int r0 = u.pm * BM + wr * 64 + fr, g0 = u.pn * 8 + wc;
        bf16_t* ob = O + (size_t)r0 * 768 + g0 * 32 + 4 * fq; const float* rb = rope + (size_t)r0 * 32 + 4 * fq;
#pragma unroll
        for (int bj = 0; bj < 2; ++bj) { const bool isrope = ((g0 + 4 * bj) % 3) == 2;
#pragma unroll
            for (int ai = 0; ai < 2; ++ai)
#pragma unroll
                for (int m = 0; m < 4; ++m) { const int ro = ai * HALF + m * 16;
                    f32x4 x1 = acc[ai][bj][m][0], x2 = acc[ai][bj][m][1];
                    if (isrope) { const f32x4 c = *(const f32x4*)(rb + ro * 32), s = *(const f32x4*)(rb + ro * 32 + 16);
                        const f32x4 y1 = x1 * c - x2 * s, y2 = x2 * c + x1 * s; x1 = y1; x2 = y2; }
                    x1 = x1 * QSCALE; x2 = x2 * QSCALE;
                    u32x2 w1, w2; w1.x = cvt_pk_bf16(x1[0], x1[1]); w1.y = cvt_pk_bf16(x1[2], x1[3]); w2.x = cvt_pk_bf16(x2[0], x2[1]); w2.y = cvt_pk_bf16(x2[2], x2[3]);
                    *(u32x2*)(ob + ro * 768 + bj * 128) = w1; *(u32x2*)(ob + ro * 768 + bj * 128 + 16) = w2; asm volatile("" ::: "memory"); } }
    }
};
struct EpiVT {
    static constexpr bool PERM = false, SWAP = false, HAS_PRE = false;
    bf16_t* VT;
    __device__ __forceinline__ void operator()(const f32x4 (&acc)[2][2][4][2], const Unit& u, int wr, int wc, int fr, int fq, const LAS float* tab) const {
        const int c0 = u.pn * BM + wc * 32 + fr, r0 = u.pm * BM + wr * 64 + 4 * fq;
        bf16_t* base = VT + ((size_t)(((r0 >> 12) * 8 + (c0 >> 6)) * 64 + (c0 & 63))) * SEQ + (r0 & 4095);
#pragma unroll
        for (int bj = 0; bj < 2; ++bj)
#pragma unroll
            for (int n = 0; n < 2; ++n)
#pragma unroll
                for (int ai = 0; ai < 2; ++ai)
#pragma unroll
                    for (int m = 0; m < 4; ++m) { const f32x4 v = acc[ai][bj][m][n]; u32x2 w; w.x = cvt_pk_bf16(v[0], v[1]); w.y = cvt_pk_bf16(v[2], v[3]);
                        *(u32x2*)(base + (size_t)(bj * 128 + n * 16) * SEQ + ai * HALF + m * 16) = w; }
    }
};
struct MergeArgs { const bf16_t* H; const bf16_t* P; const bf16_t* Wg; const bf16_t* Wbr; };
template <class EpiG, class EpiB1, class EpiB2>
__device__ __forceinline__ void gemm_merge(int wid0, LAS unsigned char* lds, const MergeArgs ma, const StaticOrder& S, const EpiG& EG, const EpiB1& EB1, const EpiB2& EB2) {
    const int tid = mk_tid(wid0);
    const int wid = __builtin_amdgcn_readfirstlane(tid >> 6), lane = tid & 63, wr = wid >> 2, wc = wid & 3, fr = lane & 15, fq = lane >> 4;
    int KG = DM, KH = 512; asm volatile("" : "+s"(KG)); asm volatile("" : "+s"(KH));
    unsigned voA0, voA1, voB0, voB1;
    { int R, C; stage_rc(tid * 16, R, C); const int Rb = (R & ~31) + perm32(R & 31);
      voA0 = (unsigned)(R * DM + C) * 2u; voA1 = (unsigned)(R * LDP + C) * 2u; voB0 = (unsigned)(Rb * KG + C) * 2u; voB1 = (unsigned)(Rb * KH + C) * 2u; }
    const size_t kstep = (size_t)(BK * 2);
    const unsigned ldsw = (unsigned)wid * 1024u;
    const int aoff = lds_byte(wr * 64 + fr, fq * 8), boff = lds_byte(wc * 32 + fr, fq * 8);
#define PG8_SA(b, h) (((b) * 2 + (h)) * HTB)
#define PG8_SB(b, h) ((4 + (b) * 2 + (h)) * HTB)
#define PG8_STG(bufoff, gbase, vo, v2) do { _Pragma("unroll") for (int _i = 0; _i < 2; ++_i) \
        __builtin_amdgcn_global_load_lds((const unsigned*)((const char*)(gbase) + (size_t)(_i * (v2)) + (vo)), (LAS unsigned*)(lds + (bufoff) + ldsw + _i * 8192), 16, 0, 0); } while (0)
#define PG8_LDA(dst, b, h) do { _Pragma("unroll") for (int m = 0; m < 4; ++m) _Pragma("unroll") for (int k = 0; k < 2; ++k) dst[m][k] = *(const LAS bf16x8*)(lds + PG8_SA(b, h) + aoff + m * 2048 + k * 1024); } while (0)
#define PG8_LDB(dst, b, h) do { _Pragma("unroll") for (int n = 0; n < 2; ++n) _Pragma("unroll") for (int k = 0; k < 2; ++k) dst[n][k] = *(const LAS bf16x8*)(lds + PG8_SB(b, h) + boff + n * 2048 + k * 1024); } while (0)
#define PG8_MMA(ai, bj, At, Bt) do { __builtin_amdgcn_s_setprio(1); _Pragma("unroll") for (int m = 0; m < 4; ++m) _Pragma("unroll") for (int n = 0; n < 2; ++n) _Pragma("unroll") for (int k = 0; k < 2; ++k) \
        acc[ai][bj][m][n] = __builtin_amdgcn_mfma_f32_16x16x32_bf16(Bt[n][k], At[m][k], acc[ai][bj][m][n], 0, 0, 0); __builtin_amdgcn_s_setprio(0); } while (0)
#define PG8_WAIT_V(n) asm volatile("s_waitcnt vmcnt(" #n ")" ::: "memory")
#define PG8_WAIT_L(n) asm volatile("s_waitcnt lgkmcnt(" #n ")" ::: "memory")
#define PG8_BAR __builtin_amdgcn_s_barrier()
#define PG8_SCHED __builtin_amdgcn_sched_barrier(0)
#define MG_ITEM(it, U, KIND, PA, PB) do { const int j_ = (it) % 6, i_ = j_ >> 1; KIND = j_ & 1; \
        PA = KIND ? (const char*)(ma.P + (i_ == 0 ? C_YA : (i_ == 1 ? C_YB : C_YC)) + (size_t)U.pm * BM * LDP) : (const char*)(ma.H + (size_t)U.pm * BM * DM); \
        PB = KIND ? (const char*)(ma.Wbr + ((size_t)i_ * DM + (size_t)U.pn * BM) * 512) : (const char*)(ma.Wg + ((size_t)i_ * DM + (size_t)U.pn * BM) * DM); } while (0)
    Unit cur, nxt; int it = 0;
    if (!S.next(0, cur)) return;
    f32x4 acc[2][2][4][2];
#pragma unroll
    for (int a = 0; a < 2; ++a)
#pragma unroll
        for (int b = 0; b < 2; ++b)
#pragma unroll
            for (int m = 0; m < 4; ++m)
#pragma unroll
                for (int n = 0; n < 2; ++n) acc[a][b][m][n] = (f32x4){0.f, 0.f, 0.f, 0.f};
    bf16x8 At[4][2], B0[2][2], B1[2][2];
    int ck; const char* cA; const char* cB; MG_ITEM(0, cur, ck, cA, cB);
    LAS float* const tab0 = (LAS float*)(lds + STAGE_BYTES);
    EG.pre(tab0, cur, tid);
    { const unsigned voA = ck ? voA1 : voA0, voB = ck ? voB1 : voB0, v2A = 128u * (ck ? LDP : DM), v2B = 128u * (unsigned)(ck ? KH : KG); const size_t hA = 2 * (size_t)v2A, hB = 2 * (size_t)v2B;
      PG8_STG(PG8_SB(0, 0), cB, voB, v2B); PG8_STG(PG8_SB(0, 1), cB + hB, voB, v2B); PG8_STG(PG8_SA(0, 0), cA, voA, v2A); PG8_STG(PG8_SA(0, 1), cA + hA, voA, v2A);
      if (wr == 1) PG8_BAR;
      PG8_WAIT_V(2); PG8_BAR;
      PG8_STG(PG8_SB(1, 0), cB + kstep, voB, v2B); PG8_STG(PG8_SA(1, 0), cA + kstep, voA, v2A); PG8_STG(PG8_SB(1, 1), cB + hB + kstep, voB, v2B);
      PG8_WAIT_V(6); PG8_BAR; }
    for (;;) {
        const int j = it % 6;
        bool has_next; int nk; const char* nA; const char* nB;
        if (j < 5) { has_next = true; nxt = cur; } else { has_next = S.next(it / 6 + 1, nxt); }
        if (has_next) MG_ITEM(it + 1, nxt, nk, nA, nB); else { nk = ck; nA = cA; nB = cB; }
        const unsigned cvoA = ck ? voA1 : voA0, cvoB = ck ? voB1 : voB0, cv2A = 128u * (ck ? LDP : DM), cv2B = 128u * (unsigned)(ck ? KH : KG); const size_t chA = 2 * (size_t)cv2A, chB = 2 * (size_t)cv2B;
        const unsigned nvoA = nk ? voA1 : voA0, nvoB = nk ? voB1 : voB0, nv2A = 128u * (nk ? LDP : DM), nv2B = 128u * (unsigned)(nk ? KH : KG); const size_t nhA = 2 * (size_t)nv2A, nhB = 2 * (size_t)nv2B;
        const int nt = (ck ? KH : KG) / BK;
        for (int t = 0; t < nt; t += 2) {
            const bool last = (t == nt - 2);
            const char* a1 = cA + (size_t)(t + 1) * kstep;
            const char* a2 = last ? nA : cA + (size_t)(t + 2) * kstep; const char* b2 = last ? nB : cB + (size_t)(t + 2) * kstep;
            const char* a3 = a2 + kstep; const char* b3 = b2 + kstep;
            const unsigned xvoA = last ? nvoA : cvoA, xvoB = last ? nvoB : cvoB, xv2A = last ? nv2A : cv2A, xv2B = last ? nv2B : cv2B; const size_t xhA = last ? nhA : chA, xhB = last ? nhB : chB;
            PG8_LDB(B0, 0, 0); PG8_LDB(B1, 0, 1); PG8_SCHED; PG8_LDA(At, 0, 0); PG8_STG(PG8_SA(1, 1), a1 + chA, cvoA, cv2A);
            PG8_WAIT_V(8); PG8_WAIT_L(0); PG8_BAR; PG8_MMA(0, 0, At, B0); PG8_MMA(0, 1, At, B1); PG8_BAR; PG8_SCHED;
            PG8_LDA(At, 0, 1); PG8_STG(PG8_SB(0, 0), b2, xvoB, xv2B); PG8_STG(PG8_SB(0, 1), b2 + xhB, xvoB, xv2B); PG8_STG(PG8_SA(0, 0), a2, xvoA, xv2A);
            PG8_WAIT_V(8); PG8_WAIT_L(0); PG8_BAR; PG8_MMA(1, 0, At, B0); PG8_MMA(1, 1, At, B1); PG8_BAR; PG8_SCHED;
            PG8_LDB(B0, 1, 0); PG8_LDB(B1, 1, 1); PG8_SCHED; PG8_LDA(At, 1, 0); PG8_STG(PG8_SA(0, 1), a2 + xhA, xvoA, xv2A);
            PG8_WAIT_V(8); PG8_WAIT_L(0); PG8_BAR; PG8_MMA(0, 0, At, B0); PG8_MMA(0, 1, At, B1); PG8_BAR; PG8_SCHED;
            PG8_LDA(At, 1, 1); PG8_STG(PG8_SB(1, 0), b3, xvoB, xv2B); PG8_STG(PG8_SB(1, 1), b3 + xhB, xvoB, xv2B); PG8_STG(PG8_SA(1, 0), a3, xvoA, xv2A);
            PG8_WAIT_V(8); PG8_WAIT_L(0); PG8_BAR; PG8_MMA(1, 0, At, B0); PG8_MMA(1, 1, At, B1); PG8_BAR; PG8_SCHED;
        }
        if (wr == 0) PG8_BAR;
        { int le; asm volatile("v_mbcnt_lo_u32_b32 %0, -1, 0\n\tv_mbcnt_hi_u32_b32 %0, -1, %0" : "=v"(le));
          const LAS float* tb = tab0 + ((it / 6) & 1) * 256;
          if ((j & 1) == 0) EG(acc, cur, wr, wc, le & 15, le >> 4, tb); else if (j == 1) EB1(acc, cur, wr, wc, le & 15, le >> 4, tb); else EB2(acc, cur, wr, wc, le & 15, le >> 4, tb); }
        if (!has_next) break;
#pragma unroll
        for (int a = 0; a < 2; ++a)
#pragma unroll
            for (int b = 0; b < 2; ++b)
#pragma unroll
                for (int m = 0; m < 4; ++m)
#pragma unroll
                    for (int n = 0; n < 2; ++n) acc[a][b][m][n] = (f32x4){0.f, 0.f, 0.f, 0.f};
        ++it; ck = nk; cA = nA; cB = nB;
        if (j == 5) { cur = nxt; EG.pre(tab0 + ((it / 6) & 1) * 256, cur, mk_tid(wid0)); }
        if (wr == 1) PG8_BAR;
    }
    PG8_WAIT_V(0);
    PG8_BAR;
#undef MG_ITEM
#undef PG8_SA
#undef PG8_SB
#undef PG8_STG
#undef PG8_LDA
#undef PG8_LDB
#undef PG8_MMA
#undef PG8_WAIT_V
#undef PG8_WAIT_L
#undef PG8_BAR
#undef PG8_SCHED
}

}

__device__ __forceinline__ void transpose_item(const float* W, int ldw, int K, bf16_t* WT, int mode, int shift, int nvalid, float* scr, int item, int nblk, int lane, const float* gain = nullptr) {
    const int kb = item / nblk, nb = item % nblk, k0 = 64 * kb, n0 = 32 * nb;
    const int n4 = n0 + 4 * (lane & 7), kr = lane >> 3;
    int src; bool valid = true;
    if (mode == 0) { src = n4 + shift; valid = n4 < nvalid; } else { src = (n4 >> 6) * 128 + (n4 & 63) + (mode == 2 ? 64 : 0); }
    f32x4 v[8];
#pragma unroll
    for (int i = 0; i < 8; ++i) v[i] = valid ? *(const f32x4*)(W + (size_t)(k0 + 8 * i + kr) * ldw + src) : (f32x4){0.f, 0.f, 0.f, 0.f};
#pragma unroll
    for (int i = 0; i < 8; ++i) { const int kk = 8 * i + kr; const float gq = gain ? gain[k0 + kk] : 1.f; float* d = scr + kk * 33 + 4 * (lane & 7);
        d[0] = v[i][0] * gq; d[1] = v[i][1] * gq; d[2] = v[i][2] * gq; d[3] = v[i][3] * gq; }
    asm volatile("s_waitcnt lgkmcnt(0)" ::: "memory");
    const int c = lane & 7;
#pragma unroll
    for (int j = 0; j < 4; ++j) { const int n = (lane >> 3) + 8 * j; const float* s = scr + (8 * c) * 33 + n;
        u32x4 o; o.x = pk2(s[0 * 33], s[1 * 33]); o.y = pk2(s[2 * 33], s[3 * 33]); o.z = pk2(s[4 * 33], s[5 * 33]); o.w = pk2(s[6 * 33], s[7 * 33]);
        *(u32x4*)(WT + (size_t)(n0 + n) * K + k0 + 8 * c) = o; }
    asm volatile("s_waitcnt lgkmcnt(0)" ::: "memory");
}
__device__ __forceinline__ void rms_row_bf16(const float* xrow, const float* gain, bf16_t* orow, int lane) {
    const f32x4* xr = (const f32x4*)xrow + lane; const f32x4* gr = (const f32x4*)gain + lane;
    f32x4 v[4]; float s = 0.f;
#pragma unroll
    for (int j = 0; j < 4; ++j) { v[j] = xr[64 * j]; s += (v[j].x * v[j].x + v[j].y * v[j].y) + (v[j].z * v[j].z + v[j].w * v[j].w); }
    const float rstd = rsqrtf(wave_sum(s) * (1.f / DM) + EPS);
    u32x2* o8 = (u32x2*)orow + lane;
#pragma unroll
    for (int j = 0; j < 4; ++j) { const f32x4 gg = gr[64 * j]; u32x2 w; w.x = pk2(v[j].x * rstd * gg.x, v[j].y * rstd * gg.y); w.y = pk2(v[j].z * rstd * gg.z, v[j].w * rstd * gg.w); o8[64 * j] = w; }
}
__device__ __forceinline__ void rms_row_f32(float* xrow, const float* gain, int lane) {
    f32x4* xr = (f32x4*)xrow + lane; const f32x4* gr = (const f32x4*)gain + lane;
    f32x4 v[4]; float s = 0.f;
#pragma unroll
    for (int j = 0; j < 4; ++j) { v[j] = xr[64 * j]; s += (v[j].x * v[j].x + v[j].y * v[j].y) + (v[j].z * v[j].z + v[j].w * v[j].w); }
    const float rstd = rsqrtf(wave_sum(s) * (1.f / DM) + EPS);
#pragma unroll
    for (int j = 0; j < 4; ++j) xr[64 * j] = v[j] * rstd * gr[64 * j];
}

struct Args { const float* in[24]; float* out; unsigned char* ws; int ph_lo, ph_hi; };
typedef const __attribute__((address_space(4))) Args* AP;

__device__ __forceinline__ void phase_weights(int wid0, int bid, const AP A, int l, unsigned char* lds, int G) {
    const int tid = mk_tid(wid0);
    const int lane = tid & 63, wave = tid >> 6;
    float* scr = (float*)(lds + wave * 16384);
    const int gw = bid * 8 + wave, NGW = G * 8;
    unsigned char* ws = A->ws;
    const float* w_in = A->in[3] + (size_t)l * DM * IN_COLS;
    const float* w_uq = A->in[8] + (size_t)l * 384 * 768;
    const float* w_ukv = A->in[9] + (size_t)l * 256 * 1024;
    const float* w_out = A->in[19] + (size_t)l * DM * DM;
    const float* w_up = A->in[21] + (size_t)l * DM * DFF;
    const float* w_dn = A->in[22] + (size_t)l * DFF * DM;
    constexpr int I0 = 16 * 128, I1 = 16 * 96, I2 = 6 * 24, I3 = 4 * 16, I4 = 4 * 16, I5 = 8 * 32, I8 = 16 * 32, I9 = 16 * 128, I10 = 64 * 32;
    constexpr int NIT = I0 + I1 + I2 + I3 + I4 + 3 * I5 + I8 + I9 + I10;
    for (int it = gw; it < NIT; it += NGW) {
        int r = it;
        if (r < I0) { transpose_item(w_in, IN_COLS, DM, (bf16_t*)(ws + WS_WIN), 0, 0, NPROJ, scr, r, 128, lane, A->in[2] + l * DM); continue; } r -= I0;
        if (r < I1) { transpose_item(w_in, IN_COLS, DM, (bf16_t*)(ws + WS_WIN) + (size_t)4096 * DM, 0, NPROJ, 1 << 30, scr, r, 96, lane, A->in[2] + l * DM); continue; } r -= I1;
        if (r < I2) { transpose_item(w_uq, 768, 384, (bf16_t*)(ws + WS_WUQ), 0, 0, 1 << 30, scr, r, 24, lane); continue; } r -= I2;
        if (r < I3) { transpose_item(w_ukv, 1024, 256, (bf16_t*)(ws + WS_WUK), 1, 0, 0, scr, r, 16, lane); continue; } r -= I3;
        if (r < I4) { transpose_item(w_ukv, 1024, 256, (bf16_t*)(ws + WS_WUV), 2, 0, 0, scr, r, 16, lane); continue; } r -= I4;
        if (r < 3 * I5) { const int i = r / I5; const float* wb = A->in[16 + i] + (size_t)l * 512 * DM;
            transpose_item(wb, DM, 512, (bf16_t*)(ws + WS_WBR) + (size_t)i * DM * 512, 0, 0, 1 << 30, scr, r % I5, 32, lane); continue; } r -= 3 * I5;
        if (r < I8) { transpose_item(w_out, DM, DM, (bf16_t*)(ws + WS_WOUT), 0, 0, 1 << 30, scr, r, 32, lane); continue; } r -= I8;
        if (r < I9) { transpose_item(w_up, DFF, DM, (bf16_t*)(ws + WS_WUP), 0, 0, 1 << 30, scr, r, 128, lane, A->in[20] + l * DM); continue; } r -= I9;
        transpose_item(w_dn, DM, DFF, (bf16_t*)(ws + WS_WDN), 0, 0, 1 << 30, scr, r, 32, lane);
    }
    if (l == 0) {
        const int* pos = (const int*)A->in[1]; float* rope = (float*)(ws + WS_ROPE);
        for (int e = bid * 512 + tid; e < MTOK * 16; e += G * 512) {
            const int row = e >> 4, i = e & 15;
            const float inv = exp2f(-(float)(2 * i) * (1.f / 32.f) * 13.287712379549449f);
            const float ang = (float)pos[row] * inv;
            double t = (double)ang * 0.15915494309189535; t -= rint(t);
            rope[row * 32 + i] = __builtin_amdgcn_cosf((float)t); rope[row * 32 + 16 + i] = __builtin_amdgcn_sinf((float)t);
        }
        if (bid == 0) { const float* lg = A->in[4]; float* lbs = (float*)(ws + WS_LBS); const int j = tid;
            const float a0 = lg[j], a1 = lg[512 + j], a2 = lg[1024 + j], a3 = lg[1536 + j]; const float mx = fmaxf(fmaxf(a0, a1), fmaxf(a2, a3));
            const float e0 = __expf(a0 - mx), e1 = __expf(a1 - mx), e2 = __expf(a2 - mx), e3 = __expf(a3 - mx); const float inv = 1.f / (e0 + e1 + e2 + e3);
            lbs[j] = 0.f; lbs[512 + j] = e1 * inv; lbs[1024 + j] = (e1 + e2) * inv; lbs[1536 + j] = (e1 + e2 + e3) * inv; }
    }
}
__device__ __forceinline__ void phase_xcast(int wid0, int bid, const float* x, bf16_t* XB, float* ssq, int G) {
    const int tid = mk_tid(wid0); const int lane = tid & 63, gw = bid * 8 + (tid >> 6), NGW = G * 8;
    for (int m0 = gw * 2; m0 < MTOK; m0 += NGW * 2) { f32x4 v[2][4];
#pragma unroll
        for (int i = 0; i < 2; ++i) { const f32x4* xr = (const f32x4*)(x + (size_t)(m0 + i) * DM) + lane;
#pragma unroll
            for (int j = 0; j < 4; ++j) v[i][j] = xr[64 * j]; }
#pragma unroll
        for (int i = 0; i < 2; ++i) { const int m = m0 + i; u32x2* o8 = (u32x2*)(XB + (size_t)m * DM) + lane; float s = 0.f;
#pragma unroll
            for (int j = 0; j < 4; ++j) { const f32x4 vv = v[i][j]; s += (vv.x * vv.x + vv.y * vv.y) + (vv.z * vv.z + vv.w * vv.w); u32x2 w; w.x = pk2(vv.x, vv.y); w.y = pk2(vv.z, vv.w); o8[64 * j] = w; }
            s = wave_sum(s); if (lane < 16) ssq[(size_t)m * 16 + lane] = lane == 0 ? s : 0.f; } }
}
__device__ __forceinline__ void phase_zero(int wid0, int bid, float* p, int n, int G) { const int tid = mk_tid(wid0); for (int i = bid * 512 + tid; i < n; i += G * 512) p[i] = 0.f; }
__device__ __forceinline__ void phase_rmsnorm(int wid0, int bid, const float* x, const float* gain, bf16_t* H, int G) {
    const int tid = mk_tid(wid0);
    const int lane = tid & 63, gw = bid * 8 + (tid >> 6), NGW = G * 8;
    for (int m = gw; m < MTOK; m += NGW) rms_row_bf16(x + (size_t)m * DM, gain, H + (size_t)m * DM, lane);
}
__device__ __forceinline__ void phase_elem(int wid0, int bid, bf16_t* P, const float* qn, const float* kvn, const float* rope, bf16_t* KRP, int G) {
    const int tid = mk_tid(wid0);
    const int lane = tid & 63, gw = bid * 8 + (tid >> 6), NGW = G * 8;
    float gq[6], gk[4];
#pragma unroll
    for (int j = 0; j < 3; ++j) { gq[2 * j] = qn[2 * lane + 128 * j]; gq[2 * j + 1] = qn[2 * lane + 128 * j + 1]; }
#pragma unroll
    for (int j = 0; j < 2; ++j) { gk[2 * j] = kvn[2 * lane + 128 * j]; gk[2 * j + 1] = kvn[2 * lane + 128 * j + 1]; }
    for (int m0 = gw * 4; m0 < MTOK; m0 += NGW * 4) {
        unsigned wq[4][3], wk[4][2]; unsigned k1[4], k2[4]; float rc[4], rsn[4];
#pragma unroll
        for (int i = 0; i < 4; ++i) { bf16_t* row = P + (size_t)(m0 + i) * LDP; const unsigned* pq = (const unsigned*)(row + C_CQ) + lane; const unsigned* pk = (const unsigned*)(row + C_CKV) + lane;
#pragma unroll
            for (int j = 0; j < 3; ++j) wq[i][j] = pq[64 * j];
#pragma unroll
            for (int j = 0; j < 2; ++j) wk[i][j] = pk[64 * j];
            k1[i] = row[C_KR + (lane & 15)]; k2[i] = row[C_KR + 16 + (lane & 15)]; rc[i] = rope[(size_t)(m0 + i) * 32 + (lane & 15)]; rsn[i] = rope[(size_t)(m0 + i) * 32 + 16 + (lane & 15)]; }
#pragma unroll
        for (int i = 0; i < 4; ++i) { bf16_t* row = P + (size_t)(m0 + i) * LDP; unsigned* pq = (unsigned*)(row + C_CQ) + lane; unsigned* pk = (unsigned*)(row + C_CKV) + lane;
            float s = 0.f;
#pragma unroll
            for (int j = 0; j < 3; ++j) { const float a = bf2f(wq[i][j] & 0xffffu), b = bf2f(wq[i][j] >> 16); s += a * a + b * b; }
            const float rq = rsqrtf(wave_sum(s) * (1.f / 384.f) + EPS);
#pragma unroll
            for (int j = 0; j < 3; ++j) pq[64 * j] = pk2(bf2f(wq[i][j] & 0xffffu) * rq * gq[2 * j], bf2f(wq[i][j] >> 16) * rq * gq[2 * j + 1]);
            float s2 = 0.f;
#pragma unroll
            for (int j = 0; j < 2; ++j) { const float a = bf2f(wk[i][j] & 0xffffu), b = bf2f(wk[i][j] >> 16); s2 += a * a + b * b; }
            const float rk = rsqrtf(wave_sum(s2) * (1.f / 256.f) + EPS);
#pragma unroll
            for (int j = 0; j < 2; ++j) pk[64 * j] = pk2(bf2f(wk[i][j] & 0xffffu) * rk * gk[2 * j], bf2f(wk[i][j] >> 16) * rk * gk[2 * j + 1]);
            if (lane < 16) { const float x1 = bf2f(k1[i]), x2 = bf2f(k2[i]);
                KRP[(size_t)(m0 + i) * 32 + lane] = (bf16_t)f2bf(x1 * rc[i] - x2 * rsn[i]); KRP[(size_t)(m0 + i) * 32 + 16 + lane] = (bf16_t)f2bf(x2 * rc[i] + x1 * rsn[i]); } }
    }
}

__device__ __forceinline__ void hgrn_gate(float ff, float lb, float oml, float& logf, float& kk) {
    ff = fminf(fmaxf(ff, -30.f), 30.f);
    const float e = __expf(-ff), sg = __builtin_amdgcn_rcpf(1.f + e);
    logf = __logf(lb + oml * sg); kk = oml * e * sg;
}
__device__ __forceinline__ void hgrn_pass1(int wid0, int bid, unsigned char* lds, const bf16_t* P, const float* lbs, bf16_t* HST, float* HGD, int G) {
    bf16_t* KbT = (bf16_t*)lds; bf16_t* VT = (bf16_t*)(lds + 18432); float* tot = (float*)(lds + 36864);
    unsigned rf[16], rvv[16];
#define HG1_LOAD(uu, tid_) do { const int kc_ = (tid_) & 127, rg_ = (tid_) >> 7; const size_t r0_ = (size_t)((uu) >> 8) * SEQ + ((uu) & 63) * 64 + rg_ * 16; const bf16_t* p_ = P + r0_ * LDP + (((uu) >> 6) & 3) * 128 + kc_; \
        _Pragma("unroll") for (int r = 0; r < 16; ++r) { rf[r] = p_[(size_t)r * LDP + C_HF]; rvv[r] = p_[(size_t)r * LDP + C_HI]; } } while (0)
    if (bid < 2048) { const int t0 = mk_tid(wid0); HG1_LOAD(bid, t0); }
    for (int u = bid; u < 2048; u += G) {
        const int tid = mk_tid(wid0);
        const int lane = tid & 63, wid = tid >> 6, r32 = lane & 31, hh = lane >> 5, kc = tid & 127, rg = tid >> 7;
        const int h = (u >> 6) & 3;
        const float lb = lbs[h * 128 + kc], oml = 1.f - lb;
        float bb[16], kk[16]; unsigned vv[16]; float run = 0.f;
#pragma unroll
        for (int r = 0; r < 16; ++r) { const float ff = bf2f(rf[r]); vv[r] = rvv[r]; float lf; hgrn_gate(ff, lb, oml, lf, kk[r]); run += lf; bb[r] = run; }
        if (u + G < 2048) HG1_LOAD(u + G, tid);
        tot[rg * 128 + kc] = run; __syncthreads();
        float off = 0.f, blast = 0.f;
#pragma unroll
        for (int g = 0; g < 4; ++g) { const float t = tot[g * 128 + kc]; if (g < rg) off += t; blast += t; }
        unsigned kw[8], vw[8];
#pragma unroll
        for (int r = 0; r < 16; r += 2) { const float k0 = kk[r] * __expf(blast - (bb[r] + off)), k1 = kk[r + 1] * __expf(blast - (bb[r + 1] + off));
            kw[r >> 1] = pk2(k0, k1); vw[r >> 1] = vv[r] | (vv[r + 1] << 16); }
        *(u32x4*)(KbT + kc * 72 + rg * 16) = (u32x4){kw[0], kw[1], kw[2], kw[3]}; *(u32x4*)(KbT + kc * 72 + rg * 16 + 8) = (u32x4){kw[4], kw[5], kw[6], kw[7]};
        *(u32x4*)(VT + kc * 72 + rg * 16) = (u32x4){vw[0], vw[1], vw[2], vw[3]}; *(u32x4*)(VT + kc * 72 + rg * 16 + 8) = (u32x4){vw[4], vw[5], vw[6], vw[7]};
        if (rg == 0) HGD[u * 128 + kc] = __expf(blast);
        __syncthreads();
        const int kb = wid >> 1, vb0 = (wid & 1) * 2;
        f32x16 a0 = {}, a1 = {};
#pragma unroll
        for (int s = 0; s < 4; ++s) { const bf16x8 a = *(const bf16x8*)(KbT + (kb * 32 + r32) * 72 + 16 * s + 8 * hh);
            const bf16x8 b0 = *(const bf16x8*)(VT + (vb0 * 32 + r32) * 72 + 16 * s + 8 * hh), b1 = *(const bf16x8*)(VT + ((vb0 + 1) * 32 + r32) * 72 + 16 * s + 8 * hh);
            a0 = MFMA32(a, b0, a0); a1 = MFMA32(a, b1, a1); }
        bf16_t* st = HST + (size_t)u * 16384;
#pragma unroll
        for (int q = 0; q < 4; ++q) { u32x2 w0, w1; w0.x = cvt_pk_bf16(a0[4 * q], a0[4 * q + 1]); w0.y = cvt_pk_bf16(a0[4 * q + 2], a0[4 * q + 3]); w1.x = cvt_pk_bf16(a1[4 * q], a1[4 * q + 1]); w1.y = cvt_pk_bf16(a1[4 * q + 2], a1[4 * q + 3]);
            *(u32x2*)(st + (vb0 * 32 + r32) * 128 + kb * 32 + 8 * q + 4 * hh) = w0; *(u32x2*)(st + ((vb0 + 1) * 32 + r32) * 128 + kb * 32 + 8 * q + 4 * hh) = w1; }
        __syncthreads();
    }
}
__device__ __forceinline__ void hgrn_scan(int wid0, int bid, bf16_t* HST, const float* HGD, int G) {
    const int tid = mk_tid(wid0);
    for (int gt = bid * 512 + tid; gt < 131072; gt += G * 512) {
        const int e0 = gt * 4, bh = e0 >> 14, idx = e0 & 16383, k = idx & 127;
        float S0 = 0.f, S1 = 0.f, S2 = 0.f, S3 = 0.f;
#pragma unroll 16
        for (int c = 0; c < 64; ++c) { const int u = bh * 64 + c; u32x2* ptr = (u32x2*)(HST + (size_t)u * 16384 + idx); const u32x2 d = *ptr; const f32x4 dv = *(const f32x4*)(HGD + u * 128 + k);
            u32x2 w; w.x = pk2(S0, S1); w.y = pk2(S2, S3); *ptr = w;
            S0 = dv.x * S0 + bf2f(d.x & 0xffffu); S1 = dv.y * S1 + bf2f(d.x >> 16); S2 = dv.z * S2 + bf2f(d.y & 0xffffu); S3 = dv.w * S3 + bf2f(d.y >> 16); }
    }
}
__device__ __forceinline__ void hgrn_pass3(int wid0, int bid, unsigned char* lds, bf16_t* yo, int ypitch, bf16_t* P, const float* lbs, const float* ngain, const bf16_t* HST, int G) {
    bf16_t* QD = (bf16_t*)lds; bf16_t* KD = (bf16_t*)(lds + 17408); bf16_t* QB = (bf16_t*)(lds + 34816); bf16_t* QO = (bf16_t*)(lds + 52224); bf16_t* KO = (bf16_t*)(lds + 60928);
    bf16_t* VT = (bf16_t*)(lds + 69632); float* tot = (float*)(lds + 88064); float* ssq = (float*)(lds + 90112);
    unsigned rq[16], rf[16], rvv[16];
#define HG3_LOAD(uu, tid_) do { const int kc_ = (tid_) & 127, rg_ = (tid_) >> 7; const size_t r0_ = (size_t)((uu) >> 8) * SEQ + ((uu) & 63) * 64 + rg_ * 16; const bf16_t* p_ = P + r0_ * LDP + (((uu) >> 6) & 3) * 128 + kc_; \
        _Pragma("unroll") for (int r = 0; r < 16; ++r) { rq[r] = p_[(size_t)r * LDP + C_HQ]; rf[r] = p_[(size_t)r * LDP + C_HF]; rvv[r] = p_[(size_t)r * LDP + C_HI]; } } while (0)
    if (bid < 2048) { const int t0 = mk_tid(wid0); HG3_LOAD(bid, t0); }
    for (int u = bid; u < 2048; u += G) {
        const int tid = mk_tid(wid0);
        const int lane = tid & 63, wid = tid >> 6, r32 = lane & 31, hh = lane >> 5, kc = tid & 127, rg = tid >> 7;
        const int b = u >> 8, h = (u >> 6) & 3, c = u & 63;
        const size_t rowc = (size_t)b * SEQ + c * 64;
        const float lb = lbs[h * 128 + kc], oml = 1.f - lb;
        float bb[16], kk[16], qq[16]; unsigned vw[8]; float run = 0.f;
#pragma unroll
        for (int r = 0; r < 16; r += 2) {
            const float f0 = bf2f(rf[r]), f1 = bf2f(rf[r + 1]); vw[r >> 1] = rvv[r] | (rvv[r + 1] << 16);
            qq[r] = siluf_(bf2f(rq[r])); qq[r + 1] = siluf_(bf2f(rq[r + 1]));
            float lf; hgrn_gate(f0, lb, oml, lf, kk[r]); run += lf; bb[r] = run; hgrn_gate(f1, lb, oml, lf, kk[r + 1]); run += lf; bb[r + 1] = run; }
        if (u + G < 2048) HG3_LOAD(u + G, tid);
        u32x2 gpre[4];
        { const bf16_t* pg = P + (rowc + (wid >> 2) * 32 + r32) * LDP + C_HG + h * 128 + (wid & 3) * 32 + 4 * hh;
#pragma unroll
          for (int q = 0; q < 4; ++q) gpre[q] = *(const u32x2*)(pg + 8 * q); }
        bf16x8 spre[8];
        { const bf16_t* st = HST + (size_t)u * 16384 + ((wid & 3) * 32 + r32) * 128 + 8 * hh;
#pragma unroll
          for (int s8 = 0; s8 < 8; ++s8) spre[s8] = *(const bf16x8*)(st + 16 * s8); }
        tot[rg * 128 + kc] = run; __syncthreads();
        const float t0 = tot[kc], t1 = tot[128 + kc], t2 = tot[256 + kc];
        const float G0 = t0, G1 = t0 + t1, G2 = G1 + t2;
        const float off = rg == 0 ? 0.f : (rg == 1 ? G0 : (rg == 2 ? G1 : G2));
        const float refD = rg < 2 ? G0 : G2;
        *(u32x4*)(VT + kc * 72 + rg * 16) = (u32x4){vw[0], vw[1], vw[2], vw[3]}; *(u32x4*)(VT + kc * 72 + rg * 16 + 8) = (u32x4){vw[4], vw[5], vw[6], vw[7]};
        const float eD = __expf(refD), eO = rg >= 2 ? __expf(refD - G1) : __expf(G1 - refD);
#pragma unroll
        for (int r = 0; r < 16; ++r) { const int i = rg * 16 + r; const float bi = bb[r] + off;
            const float qe = qq[r] * __expf(fminf(bi - refD, 80.f)), ke = kk[r] * __expf(fminf(refD - bi, 80.f));
            QD[i * 136 + kc] = (bf16_t)f2bf(qe); KD[i * 136 + kc] = (bf16_t)f2bf(ke);
            QB[i * 136 + kc] = (bf16_t)f2bf(qe * eD);
            if (rg >= 2) QO[(i - 32) * 136 + kc] = (bf16_t)f2bf(qe * eO); else KO[i * 136 + kc] = (bf16_t)f2bf(ke * eO); }
        __syncthreads();
        const int vb = wid & 3, ib = wid >> 2;
        f32x16 o = {};
        {
#pragma unroll
          for (int s = 0; s < 8; ++s) { const bf16x8 a = spre[s]; const bf16x8 bq = *(const bf16x8*)(QB + (ib * 32 + r32) * 136 + 16 * s + 8 * hh); o = MFMA32(a, bq, o); } }
        { f32x16 at = {};
#pragma unroll
          for (int s = 0; s < 8; ++s) { const bf16x8 a = *(const bf16x8*)(KD + (ib * 32 + r32) * 136 + 16 * s + 8 * hh); const bf16x8 bq = *(const bf16x8*)(QD + (ib * 32 + r32) * 136 + 16 * s + 8 * hh); at = MFMA32(a, bq, at); }
#pragma unroll
          for (int r = 0; r < 16; ++r) if (crow(r, hh) > r32) at[r] = 0.f;
#pragma unroll
          for (int s2 = 0; s2 < 2; ++s2) { const bf16x8 bf = pack8(at, s2); const unsigned char* vp = (const unsigned char*)(VT + (vb * 32 + r32) * 72 + ib * 32 + 16 * s2 + 4 * hh);
              o = MFMA32(ld2x64(vp, vp + 16), bf, o); } }
        if (ib == 1) { f32x16 at = {};
#pragma unroll
          for (int s = 0; s < 8; ++s) { const bf16x8 a = *(const bf16x8*)(KO + r32 * 136 + 16 * s + 8 * hh); const bf16x8 bq = *(const bf16x8*)(QO + r32 * 136 + 16 * s + 8 * hh); at = MFMA32(a, bq, at); }
#pragma unroll
          for (int s2 = 0; s2 < 2; ++s2) { const bf16x8 bf = pack8(at, s2); const unsigned char* vp = (const unsigned char*)(VT + (vb * 32 + r32) * 72 + 16 * s2 + 4 * hh);
              o = MFMA32(ld2x64(vp, vp + 16), bf, o); } }
        float sq = 0.f;
#pragma unroll
        for (int r = 0; r < 16; ++r) sq += o[r] * o[r];
        sq += __shfl_xor(sq, 32);
        if (hh == 0) ssq[(ib * 32 + r32) * 4 + vb] = sq;
        __syncthreads();
        const f32x4 sv = *(const f32x4*)(ssq + (ib * 32 + r32) * 4);
        const float rstd = rsqrtf((sv.x + sv.y + sv.z + sv.w) * (1.f / 128.f) + EPS);
        bf16_t* prow = P + (rowc + ib * 32 + r32) * LDP;
#pragma unroll
        for (int q = 0; q < 4; ++q) { const int v0 = h * 128 + vb * 32 + 8 * q + 4 * hh; const u32x2 gw = gpre[q]; const f32x4 ng = *(const f32x4*)(ngain + v0);
            const float y0 = o[4 * q] * rstd * ng.x * siluf_(bf2f(gw.x & 0xffffu)), y1 = o[4 * q + 1] * rstd * ng.y * siluf_(bf2f(gw.x >> 16));
            const float y2 = o[4 * q + 2] * rstd * ng.z * siluf_(bf2f(gw.y & 0xffffu)), y3 = o[4 * q + 3] * rstd * ng.w * siluf_(bf2f(gw.y >> 16));
            u32x2 w; w.x = pk2(y0, y1); w.y = pk2(y2, y3); *(u32x2*)(yo + (rowc + ib * 32 + r32) * ypitch + v0) = w; }
        __syncthreads();
    }
}

__device__ __forceinline__ float softplusf_(float x) { if (x > 15.f) return x; const float e = __expf(x); return e < 1e-3f ? e * (1.f - 0.5f * e) : __logf(1.f + e); }
__device__ __forceinline__ void mamba_dt(int tid, const bf16_t* P, size_t row0, int g, const float* dt_bias, const float* a_log, float* dtv, float* acum, float* wtot) {
    const int lane = tid & 63, wid = tid >> 6; const int hl = wid >> 1, l = (wid & 1) * 64 + lane, head = g * 4 + hl;
    const float dt = softplusf_(bf2f(P[(row0 + l) * LDP + C_DT + head]) + dt_bias[head]);
    float v = -__expf(a_log[head]) * dt;
#pragma unroll
    for (int o = 1; o < 64; o <<= 1) { const float t = __shfl_up(v, o); if (lane >= o) v += t; }
    if (lane == 63) wtot[wid] = v;
    __syncthreads();
    if (wid & 1) v += wtot[wid - 1];
    acum[hl * 128 + l] = v; dtv[hl * 128 + l] = dt;
    __syncthreads();
}
__device__ __forceinline__ void mamba_pass1(int wid0, int bid, unsigned char* lds, const bf16_t* P, const float* cw, const float* cb, const float* dt_bias, const float* a_log, bf16_t* MS, float* MAT, int G) {
    bf16_t* XwT = (bf16_t*)lds; bf16_t* BT = (bf16_t*)(lds + 69632); float* dtv = (float*)(lds + 87040); float* acum = (float*)(lds + 89088); float* wtot = (float*)(lds + 91136);
    for (int u = bid; u < 512; u += G) {
        const int tid = mk_tid(wid0);
        const int lane = tid & 63, wid = tid >> 6, r32 = lane & 31, hh = lane >> 5;
        const int b = u >> 6, c = (u >> 1) & 31, g = u & 1; const size_t row0 = (size_t)b * SEQ + c * 128;
        const int ch = tid & 255, rh = tid >> 8, chanx = g * 256 + ch, hlx = ch >> 6, lx0 = rh * 64;
        const bf16_t* pxx = P + row0 * LDP + C_XBC + chanx; const int tokx = c * 128 + lx0;
        unsigned rx[64]; unsigned hx3 = 0, hx2 = 0, hx1 = 0;
        if (tokx >= 3) { hx3 = pxx[(ptrdiff_t)(lx0 - 3) * LDP]; hx2 = pxx[(ptrdiff_t)(lx0 - 2) * LDP]; hx1 = pxx[(ptrdiff_t)(lx0 - 1) * LDP]; }
#pragma unroll
        for (int i = 0; i < 64; ++i) rx[i] = pxx[(size_t)(lx0 + i) * LDP];
        const int nB = tid & 63, rgp = tid >> 6, chanb = 512 + g * 64 + nB, lb0 = rgp * 16;
        const bf16_t* pxb = P + row0 * LDP + C_XBC + chanb; const int tokb = c * 128 + lb0;
        unsigned rb[16]; unsigned hb3 = 0, hb2 = 0, hb1 = 0;
        if (tokb >= 3) { hb3 = pxb[(ptrdiff_t)(lb0 - 3) * LDP]; hb2 = pxb[(ptrdiff_t)(lb0 - 2) * LDP]; hb1 = pxb[(ptrdiff_t)(lb0 - 1) * LDP]; }
#pragma unroll
        for (int i = 0; i < 16; ++i) rb[i] = pxb[(size_t)(lb0 + i) * LDP];
        const float wx0 = cw[chanx], wx1 = cw[768 + chanx], wx2 = cw[1536 + chanx], wx3 = cw[2304 + chanx], bx = cb[chanx];
        const float wb0 = cw[chanb], wb1 = cw[768 + chanb], wb2 = cw[1536 + chanb], wb3 = cw[2304 + chanb], bbv = cb[chanb];
        mamba_dt(tid, P, row0, g, dt_bias, a_log, dtv, acum, wtot);
        { float x3 = bf2f(hx3), x2 = bf2f(hx2), x1 = bf2f(hx1); const float alast = acum[hlx * 128 + 127];
#pragma unroll
          for (int k8 = 0; k8 < 8; ++k8) { unsigned w[4];
#pragma unroll
              for (int e = 0; e < 8; e += 2) { float xv[2];
#pragma unroll
                  for (int e2 = 0; e2 < 2; ++e2) { const int l = lx0 + k8 * 8 + e + e2; const float xin = bf2f(rx[k8 * 8 + e + e2]); const float cv = wx0 * x3 + wx1 * x2 + wx2 * x1 + wx3 * xin + bx; x3 = x2; x2 = x1; x1 = xin;
                      xv[e2] = siluf_(cv) * dtv[hlx * 128 + l] * __expf(alast - acum[hlx * 128 + l]); }
                  w[e >> 1] = pk2(xv[0], xv[1]); }
              *(u32x4*)(XwT + ch * 136 + lx0 + k8 * 8) = (u32x4){w[0], w[1], w[2], w[3]}; } }
        { float x3 = bf2f(hb3), x2 = bf2f(hb2), x1 = bf2f(hb1); unsigned w[8];
#pragma unroll
          for (int e = 0; e < 16; e += 2) { float xv[2];
#pragma unroll
              for (int e2 = 0; e2 < 2; ++e2) { const float xin = bf2f(rb[e + e2]); const float cv = wb0 * x3 + wb1 * x2 + wb2 * x1 + wb3 * xin + bbv; x3 = x2; x2 = x1; x1 = xin; xv[e2] = siluf_(cv); }
              w[e >> 1] = pk2(xv[0], xv[1]); }
          *(u32x4*)(BT + nB * 136 + lb0) = (u32x4){w[0], w[1], w[2], w[3]}; *(u32x4*)(BT + nB * 136 + lb0 + 8) = (u32x4){w[4], w[5], w[6], w[7]}; }
        __syncthreads();
        { const int hl = wid >> 1, nb = wid & 1, head = g * 4 + hl;
          f32x16 a0 = {}, a1 = {};
#pragma unroll
          for (int s = 0; s < 8; ++s) { const bf16x8 a = *(const bf16x8*)(BT + (nb * 32 + r32) * 136 + 16 * s + 8 * hh);
              const bf16x8 b0 = *(const bf16x8*)(XwT + (hl * 64 + r32) * 136 + 16 * s + 8 * hh), b1 = *(const bf16x8*)(XwT + (hl * 64 + 32 + r32) * 136 + 16 * s + 8 * hh);
              a0 = MFMA32(a, b0, a0); a1 = MFMA32(a, b1, a1); }
          bf16_t* ms = MS + (size_t)((b * 32 + c) * 8 + head) * 4096;
#pragma unroll
          for (int q = 0; q < 4; ++q) { u32x2 w0, w1; w0.x = cvt_pk_bf16(a0[4 * q], a0[4 * q + 1]); w0.y = cvt_pk_bf16(a0[4 * q + 2], a0[4 * q + 3]); w1.x = cvt_pk_bf16(a1[4 * q], a1[4 * q + 1]); w1.y = cvt_pk_bf16(a1[4 * q + 2], a1[4 * q + 3]);
              *(u32x2*)(ms + r32 * 64 + nb * 32 + 8 * q + 4 * hh) = w0; *(u32x2*)(ms + (32 + r32) * 64 + nb * 32 + 8 * q + 4 * hh) = w1; }
          if (tid < 4) MAT[(b * 32 + c) * 8 + g * 4 + tid] = acum[tid * 128 + 127]; }
        __syncthreads();
    }
}
__device__ __forceinline__ void mamba_scan(int wid0, int bid, bf16_t* MS, const float* MAT, int G) {
    const int tid = mk_tid(wid0);
    for (int gt = bid * 512 + tid; gt < 131072; gt += G * 512) {
        const int e0 = gt * 2, bhd = e0 >> 12, b = bhd >> 3, head = bhd & 7, idx = e0 & 4095;
        float S0 = 0.f, S1 = 0.f;
#pragma unroll 16
        for (int c = 0; c < 32; ++c) { const int ui = (b * 32 + c) * 8 + head; unsigned* ptr = (unsigned*)(MS + (size_t)ui * 4096 + idx); const unsigned d = *ptr; const float dec = __expf(MAT[ui]);
            *ptr = pk2(S0, S1);
            S0 = dec * S0 + bf2f(d & 0xffffu); S1 = dec * S1 + bf2f(d >> 16); }
    }
}
__device__ __forceinline__ void mamba_pass3(int wid0, int bid, unsigned char* lds, bf16_t* yo, int ypitch, bf16_t* P, const float* cw, const float* cb, const float* dt_bias, const float* a_log, const float* dsk, const float* ngain, const bf16_t* MS, int G) {
    bf16_t* XT = (bf16_t*)lds; bf16_t* Brow = (bf16_t*)(lds + 69632); bf16_t* Crow = (bf16_t*)(lds + 88064);
    float* dtv = (float*)(lds + 106496); float* acum = (float*)(lds + 108544); float* ssq = (float*)(lds + 110592); float* wtot = (float*)(lds + 111616);
    for (int u = bid; u < 512; u += G) {
        const int tid = mk_tid(wid0);
        const int lane = tid & 63, wid = tid >> 6, r32 = lane & 31, hh = lane >> 5;
        const int b = u >> 6, c = (u >> 1) & 31, g = u & 1; const size_t row0 = (size_t)b * SEQ + c * 128;
        const int ch = tid & 255, rh = tid >> 8, chanx = g * 256 + ch, lx0 = rh * 64;
        const bf16_t* pxx = P + row0 * LDP + C_XBC + chanx; const int tokx = c * 128 + lx0;
        unsigned rx[64]; unsigned hx3 = 0, hx2 = 0, hx1 = 0;
        if (tokx >= 3) { hx3 = pxx[(ptrdiff_t)(lx0 - 3) * LDP]; hx2 = pxx[(ptrdiff_t)(lx0 - 2) * LDP]; hx1 = pxx[(ptrdiff_t)(lx0 - 1) * LDP]; }
#pragma unroll
        for (int i = 0; i < 64; ++i) rx[i] = pxx[(size_t)(lx0 + i) * LDP];
        const int nB = tid & 63, rgp = tid >> 6, lb0 = rgp * 16; const int tokb = c * 128 + lb0;
        const bf16_t* pxb = P + row0 * LDP + C_XBC + 512 + g * 64 + nB;
        unsigned rb[2][16]; unsigned hb[2][3] = {{0, 0, 0}, {0, 0, 0}};
#pragma unroll
        for (int wh = 0; wh < 2; ++wh) {
            if (tokb >= 3) { hb[wh][0] = pxb[(ptrdiff_t)(lb0 - 3) * LDP + wh * 128]; hb[wh][1] = pxb[(ptrdiff_t)(lb0 - 2) * LDP + wh * 128]; hb[wh][2] = pxb[(ptrdiff_t)(lb0 - 1) * LDP + wh * 128]; }
#pragma unroll
            for (int i = 0; i < 16; ++i) rb[wh][i] = pxb[(size_t)(lb0 + i) * LDP + wh * 128]; }
        const float wx0 = cw[chanx], wx1 = cw[768 + chanx], wx2 = cw[1536 + chanx], wx3 = cw[2304 + chanx], bx = cb[chanx];
        mamba_dt(tid, P, row0, g, dt_bias, a_log, dtv, acum, wtot);
        { float x3 = bf2f(hx3), x2 = bf2f(hx2), x1 = bf2f(hx1);
#pragma unroll
          for (int k8 = 0; k8 < 8; ++k8) { unsigned w[4];
#pragma unroll
              for (int e = 0; e < 8; e += 2) { float xv[2];
#pragma unroll
                  for (int e2 = 0; e2 < 2; ++e2) { const float xin = bf2f(rx[k8 * 8 + e + e2]); const float cv = wx0 * x3 + wx1 * x2 + wx2 * x1 + wx3 * xin + bx; x3 = x2; x2 = x1; x1 = xin; xv[e2] = siluf_(cv); }
                  w[e >> 1] = pk2(xv[0], xv[1]); }
              *(u32x4*)(XT + ch * 136 + lx0 + k8 * 8) = (u32x4){w[0], w[1], w[2], w[3]}; } }
#pragma unroll
        for (int wh = 0; wh < 2; ++wh) { const int chan = 512 + wh * 128 + g * 64 + nB; bf16_t* dst = wh ? Crow : Brow;
            const float w0 = cw[chan], w1 = cw[768 + chan], w2 = cw[1536 + chan], w3 = cw[2304 + chan], bias = cb[chan];
            float x3 = bf2f(hb[wh][0]), x2 = bf2f(hb[wh][1]), x1 = bf2f(hb[wh][2]);
#pragma unroll
            for (int e = 0; e < 16; ++e) { const float xin = bf2f(rb[wh][e]); const float cv = w0 * x3 + w1 * x2 + w2 * x1 + w3 * xin + bias; x3 = x2; x2 = x1; x1 = xin;
                dst[(lb0 + e) * 72 + nB] = (bf16_t)f2bf(siluf_(cv)); } }
        __syncthreads();
        const int lblk = wid & 3, hp = wid >> 2;
        f32x16 y[2][2] = {};
        for (int sb = 0; sb <= lblk; ++sb) {
            f32x16 gt = {};
#pragma unroll
            for (int s = 0; s < 4; ++s) { const bf16x8 a = *(const bf16x8*)(Brow + (sb * 32 + r32) * 72 + 16 * s + 8 * hh); const bf16x8 bq = *(const bf16x8*)(Crow + (lblk * 32 + r32) * 72 + 16 * s + 8 * hh); gt = MFMA32(a, bq, gt); }
#pragma unroll
            for (int hi2 = 0; hi2 < 2; ++hi2) { const int hl = 2 * hp + hi2; const float al = acum[hl * 128 + lblk * 32 + r32]; const float dk = dsk[g * 4 + hl];
                f32x16 m;
#pragma unroll
                for (int r = 0; r < 16; ++r) { const int sl = crow(r, hh); const float v = gt[r] * __expf(al - acum[hl * 128 + sb * 32 + sl]) * dtv[hl * 128 + sb * 32 + sl];
                    m[r] = (sb < lblk || sl < r32) ? v : (sl == r32 ? v + dk : 0.f); }
#pragma unroll
                for (int s2 = 0; s2 < 2; ++s2) { const bf16x8 bf = pack8(m, s2);
#pragma unroll
                    for (int pb = 0; pb < 2; ++pb) { const unsigned char* xp = (const unsigned char*)(XT + (hl * 64 + pb * 32 + r32) * 136 + sb * 32 + 16 * s2 + 4 * hh); y[hi2][pb] = MFMA32(ld2x64(xp, xp + 16), bf, y[hi2][pb]); } } asm volatile("" ::: "memory"); }
        }
#pragma unroll
        for (int hi2 = 0; hi2 < 2; ++hi2) { const int hl = 2 * hp + hi2, head = g * 4 + hl; const float ea = __expf(acum[hl * 128 + lblk * 32 + r32]);
#pragma unroll
            for (int pb = 0; pb < 2; ++pb) { f32x16 t = {}; const bf16_t* sp = MS + ((size_t)((b * 32 + c) * 8 + head) * 64 + pb * 32 + r32) * 64;
#pragma unroll
                for (int s = 0; s < 4; ++s) { const bf16x8 a = *(const bf16x8*)(sp + 16 * s + 8 * hh); const bf16x8 bq = *(const bf16x8*)(Crow + (lblk * 32 + r32) * 72 + 16 * s + 8 * hh); t = MFMA32(a, bq, t); }
#pragma unroll
                for (int r = 0; r < 16; ++r) y[hi2][pb][r] += t[r] * ea; asm volatile("" ::: "memory"); } }
        bf16_t* prow = P + (row0 + lblk * 32 + r32) * LDP;
        float sq = 0.f;
#pragma unroll
        for (int hi2 = 0; hi2 < 2; ++hi2)
#pragma unroll
            for (int pb = 0; pb < 2; ++pb)
#pragma unroll
                for (int q = 0; q < 4; ++q) { const int chl = g * 256 + (2 * hp + hi2) * 64 + pb * 32 + 8 * q + 4 * hh; const u32x2 zw = *(const u32x2*)(prow + C_SZ + chl);
                    y[hi2][pb][4 * q] *= siluf_(bf2f(zw.x & 0xffffu)); y[hi2][pb][4 * q + 1] *= siluf_(bf2f(zw.x >> 16)); y[hi2][pb][4 * q + 2] *= siluf_(bf2f(zw.y & 0xffffu)); y[hi2][pb][4 * q + 3] *= siluf_(bf2f(zw.y >> 16));
#pragma unroll
                    for (int e = 0; e < 4; ++e) sq += y[hi2][pb][4 * q + e] * y[hi2][pb][4 * q + e]; if (q & 1) asm volatile("" ::: "memory"); }
        sq += __shfl_xor(sq, 32);
        if (hh == 0) ssq[(lblk * 32 + r32) * 2 + hp] = sq;
        __syncthreads();
        const float rstd = rsqrtf((ssq[(lblk * 32 + r32) * 2] + ssq[(lblk * 32 + r32) * 2 + 1]) * (1.f / 256.f) + EPS);
#pragma unroll
        for (int hi2 = 0; hi2 < 2; ++hi2)
#pragma unroll
            for (int pb = 0; pb < 2; ++pb)
#pragma unroll
                for (int q = 0; q < 4; ++q) { const int chl = g * 256 + (2 * hp + hi2) * 64 + pb * 32 + 8 * q + 4 * hh; const f32x4 ng = *(const f32x4*)(ngain + chl);
                    u32x2 w; w.x = pk2(y[hi2][pb][4 * q] * rstd * ng.x, y[hi2][pb][4 * q + 1] * rstd * ng.y); w.y = pk2(y[hi2][pb][4 * q + 2] * rstd * ng.z, y[hi2][pb][4 * q + 3] * rstd * ng.w);
                    *(u32x2*)(yo + (row0 + lblk * 32 + r32) * ypitch + chl) = w; if (q & 1) asm volatile("" ::: "memory"); }
        __syncthreads();
    }
}

constexpr int AT_KB = 26624, AT_VB = 17408, AT_VOFF = 2 * AT_KB, AT_VP = 132;
__device__ __forceinline__ void attn_pv(f32x16& o0, f32x16& o1, const bf16x8 (&pp)[8], const bf16_t* Vs, int r32, int hh) {
#pragma unroll
    for (int s = 0; s < 8; ++s) { const unsigned char* v0 = (const unsigned char*)(Vs + r32 * AT_VP + 16 * s + 4 * hh); const unsigned char* v1 = (const unsigned char*)(Vs + (32 + r32) * AT_VP + 16 * s + 4 * hh);
        o0 = MFMA32(ld2x64(v0, v0 + 16), pp[s], o0); o1 = MFMA32(ld2x64(v1, v1 + 16), pp[s], o1); }
}
__device__ __forceinline__ void attn_unit(int tid, unsigned char* lds, int b, int h, int qb, const bf16_t* Q, const bf16_t* KN, const bf16_t* KRP, const bf16_t* VT, bf16_t* P) {
    const int lane = tid & 63, wid = tid >> 6, r32 = lane & 31, hh = lane >> 5;
    const bool grpB = false;
    const size_t rowb = (size_t)b * SEQ; const int q0 = qb * 256, qw0 = q0 + wid * 32;
    bf16x8 qf[6];
    { const bf16_t* qp = Q + (rowb + qw0 + r32) * 768 + h * 96 + 8 * hh;
#pragma unroll
      for (int s = 0; s < 6; ++s) qf[s] = *(const bf16x8*)(qp + 16 * s); }
    const int NT = (q0 + 256) / 128, ntw = (qw0 + 31) / 128 + 1;
    const bf16_t* kp = KN + (rowb + (tid >> 3)) * 512 + h * 64 + (tid & 7) * 8;
    const bf16_t* rp = KRP + (rowb + (tid >> 2)) * 32 + (tid & 3) * 8;
    const bf16_t* vp = VT + ((size_t)((b * 8 + h) * 64 + (tid >> 3))) * SEQ + (tid & 7) * 8;
    u32x4 k0r, k1r, rr, v0r, v1r;
#define AT_LD(tt) do { k0r = *(const u32x4*)(kp + (size_t)(tt) * 128 * 512); k1r = *(const u32x4*)(kp + ((size_t)(tt) * 128 + 64) * 512); rr = *(const u32x4*)(rp + (size_t)(tt) * 128 * 32); \
        v0r = *(const u32x4*)(vp + (tt) * 128); v1r = *(const u32x4*)(vp + (tt) * 128 + 64); } while (0)
#define AT_ST(kb, vb) do { bf16_t* Kw = (bf16_t*)(lds + AT_KB * (kb)); bf16_t* Vw = (bf16_t*)(lds + AT_VOFF + AT_VB * (vb)); \
        *(u32x4*)(Kw + (tid >> 3) * 104 + (tid & 7) * 8) = k0r; *(u32x4*)(Kw + (64 + (tid >> 3)) * 104 + (tid & 7) * 8) = k1r; *(u32x4*)(Kw + (tid >> 2) * 104 + 64 + (tid & 3) * 8) = rr; \
        bf16_t* vr = Vw + (tid >> 3) * AT_VP + (tid & 7) * 8; *(u32x2*)vr = (u32x2){v0r.x, v0r.y}; *(u32x2*)(vr + 4) = (u32x2){v0r.z, v0r.w}; *(u32x2*)(vr + 64) = (u32x2){v1r.x, v1r.y}; *(u32x2*)(vr + 68) = (u32x2){v1r.z, v1r.w}; } while (0)
    AT_LD(0);
    float mrun = -INFINITY, lrun = 0.f; f32x16 o0 = {}, o1 = {};
    const int qpos = qw0 + r32;
    bf16x8 pp[8] = {};
    AT_ST(0, 0);
    int vcur = 0, vprev = 2;
    if (NT > 1) AT_LD(1);
    __syncthreads();
    for (int t = 0; t < NT; ++t) {
        const int vnext = (vcur == 2) ? 0 : vcur + 1;
        if (t + 1 < NT) AT_ST((t + 1) & 1, vnext);
        if (t + 2 < NT) AT_LD(t + 2);
        const bf16_t* Ks = (const bf16_t*)(lds + AT_KB * (t & 1)); const bf16_t* Vs = (const bf16_t*)(lds + AT_VOFF + AT_VB * vcur);
        if (grpB && t > 0 && t - 1 < ntw) attn_pv(o0, o1, pp, (const bf16_t*)(lds + AT_VOFF + AT_VB * vprev), r32, hh);
        if (t < ntw) {
            f32x16 p[4] = {};
#pragma unroll
            for (int s = 0; s < 6; ++s)
#pragma unroll
                for (int blk = 0; blk < 4; ++blk) { const bf16x8 a = *(const bf16x8*)(Ks + (32 * blk + r32) * 104 + 16 * s + 8 * hh); p[blk] = MFMA32(a, qf[s], p[blk]); }
            if (t * 128 + 127 > qw0) {
#pragma unroll
                for (int blk = 0; blk < 4; ++blk)
#pragma unroll
                    for (int r = 0; r < 16; ++r) { const int kv = t * 128 + 32 * blk + crow(r, hh); if (kv > qpos) p[blk][r] = -INFINITY; } }
            float rm0 = fmaxf(fmaxf(p[0][0], p[1][0]), fmaxf(p[2][0], p[3][0])), rm1 = fmaxf(fmaxf(p[0][1], p[1][1]), fmaxf(p[2][1], p[3][1]));
            float rm2 = fmaxf(fmaxf(p[0][2], p[1][2]), fmaxf(p[2][2], p[3][2])), rm3 = fmaxf(fmaxf(p[0][3], p[1][3]), fmaxf(p[2][3], p[3][3]));
#pragma unroll
            for (int r = 4; r < 16; r += 4) {
                rm0 = fmaxf(rm0, fmaxf(fmaxf(p[0][r], p[1][r]), fmaxf(p[2][r], p[3][r]))); rm1 = fmaxf(rm1, fmaxf(fmaxf(p[0][r + 1], p[1][r + 1]), fmaxf(p[2][r + 1], p[3][r + 1])));
                rm2 = fmaxf(rm2, fmaxf(fmaxf(p[0][r + 2], p[1][r + 2]), fmaxf(p[2][r + 2], p[3][r + 2]))); rm3 = fmaxf(rm3, fmaxf(fmaxf(p[0][r + 3], p[1][r + 3]), fmaxf(p[2][r + 3], p[3][r + 3]))); }
            float rm = fmaxf(fmaxf(rm0, rm1), fmaxf(rm2, rm3));
            rm = fmaxf(rm, __shfl_xor(rm, 32));
            const float mnew = fmaxf(mrun, rm);
            if (__any(mnew > mrun)) {
                const float alpha = __builtin_amdgcn_exp2f(mrun - mnew); lrun *= alpha;
#pragma unroll
                for (int r = 0; r < 16; ++r) { o0[r] *= alpha; o1[r] *= alpha; } }
            mrun = mnew;
            float ps0 = 0.f, ps1 = 0.f, ps2 = 0.f, ps3 = 0.f;
#pragma unroll
            for (int blk = 0; blk < 4; ++blk) {
#pragma unroll
                for (int r = 0; r < 16; r += 4) {
                    p[blk][r] = __builtin_amdgcn_exp2f(p[blk][r] - mnew); ps0 += p[blk][r]; p[blk][r + 1] = __builtin_amdgcn_exp2f(p[blk][r + 1] - mnew); ps1 += p[blk][r + 1];
                    p[blk][r + 2] = __builtin_amdgcn_exp2f(p[blk][r + 2] - mnew); ps2 += p[blk][r + 2]; p[blk][r + 3] = __builtin_amdgcn_exp2f(p[blk][r + 3] - mnew); ps3 += p[blk][r + 3]; }
                pp[2 * blk] = pack8(p[blk], 0); pp[2 * blk + 1] = pack8(p[blk], 1); }
            lrun += (ps0 + ps1) + (ps2 + ps3);
            if (!grpB) attn_pv(o0, o1, pp, Vs, r32, hh);
        }
        __syncthreads();
        vprev = vcur; vcur = vnext;
    }
#undef AT_LD
#undef AT_ST
    if (grpB && NT - 1 < ntw) attn_pv(o0, o1, pp, (const bf16_t*)(lds + AT_VOFF + AT_VB * vprev), r32, hh);
    lrun += __shfl_xor(lrun, 32);
    const float il = 1.f / lrun;
    bf16_t* orow = P + (rowb + qpos) * LDP + C_YB + h * 64;
#pragma unroll
    for (int q = 0; q < 4; ++q) { u32x2 w0, w1; w0.x = pk2(o0[4 * q] * il, o0[4 * q + 1] * il); w0.y = pk2(o0[4 * q + 2] * il, o0[4 * q + 3] * il); w1.x = pk2(o1[4 * q] * il, o1[4 * q + 1] * il); w1.y = pk2(o1[4 * q + 2] * il, o1[4 * q + 3] * il);
        *(u32x2*)(orow + 8 * q + 4 * hh) = w0; *(u32x2*)(orow + 32 + 8 * q + 4 * hh) = w1; }
    __syncthreads();
}
__device__ __forceinline__ void phase_attn(int wid0, int bid, unsigned char* lds, const bf16_t* Q, const bf16_t* KN, const bf16_t* KRP, const bf16_t* VT, bf16_t* P, int G) {
    const int tid = mk_tid(wid0);
    if (G == 256) { const int bx = bid, vcu = (bx % 8) * 32 + bx / 8, bh = vcu >> 2, s = vcu & 3;
        for (int i = 0; i < 4; ++i) { const int qb = (i == 0) ? 15 - s : (i == 1) ? s : (i == 2) ? 8 + s : 7 - s; attn_unit(tid, lds, bh >> 3, bh & 7, qb, Q, KN, KRP, VT, P); } }
    else for (int u = bid; u < 1024; u += G) attn_unit(tid, lds, u >> 7, (u >> 4) & 7, 15 - (u & 15), Q, KN, KRP, VT, P);
}

#define XB_TMO      128
#define XB_XCNT(j)  (256  + 64 * (j))
#define XB_XSUB(j)  (1280 + 64 * (j))
#define XB_XGEN(j)  (2304 + 64 * (j))
#define XB_TOP      3328
#define XB_TOPGEN   3392
#define XCD_BAR_WORDS 3456
#define XB_SPIN_CAP (1u << 20)
__device__ __forceinline__ unsigned xb_ld(unsigned* p)              { return __hip_atomic_load(p, __ATOMIC_RELAXED, __HIP_MEMORY_SCOPE_AGENT); }
__device__ __forceinline__ unsigned xb_add(unsigned* p, unsigned v) { return __hip_atomic_fetch_add(p, v, __ATOMIC_RELAXED, __HIP_MEMORY_SCOPE_AGENT); }
__device__ __forceinline__ unsigned xb_xcc_id() { return (unsigned)__builtin_amdgcn_s_getreg((3 << 11) | 20) & 0xFu; }
#define XB_SPIN(cond, bar) do { unsigned _sp = 0; while (cond) { __builtin_amdgcn_s_sleep(1); \
    if ((++_sp & 255u) == 0u) { if (xb_ld(&(bar)[XB_TMO])) break; if (_sp > XB_SPIN_CAP) { atomicAdd(&(bar)[XB_TMO], 1u); break; } } } } while (0)
__device__ __forceinline__ void xcd_barrier_complete(unsigned* bar, unsigned x, unsigned G, unsigned& nloc, unsigned& nx) {
    unsigned sum, cnt, mine, sp = 0u;
    for (;;) {
        sum = 0u; cnt = 0u; mine = 0u;
#pragma unroll
        for (unsigned j = 0; j < 16; ++j) { const unsigned c = xb_ld(&bar[XB_XCNT(j)]); sum += c; cnt += (c > 0u) ? 1u : 0u; mine = (j == x) ? c : mine; }
        if (sum == G) break;
        __builtin_amdgcn_s_sleep(1);
        if ((++sp & 255u) == 0u) { if (xb_ld(&bar[XB_TMO])) break; if (sp > XB_SPIN_CAP) { atomicAdd(&bar[XB_TMO], 1u); break; } }
    }
    nloc = mine > 0u ? mine : 1u; nx = cnt > 0u ? cnt : 1u;
}
__device__ __forceinline__ void xcd_barrier(unsigned* bar, volatile LAS unsigned* st, bool leader_thread, unsigned G) {
    asm volatile("s_waitcnt vmcnt(0)" ::: "memory");
    __syncthreads();
    if (leader_thread) {
        const unsigned x = xb_xcc_id();
        __builtin_amdgcn_s_waitcnt(0);
        unsigned nloc = st[0], nx = st[1];
        if (nloc == 0u) { xcd_barrier_complete(bar, x, G, nloc, nx); st[0] = nloc; st[1] = nx; }
        const unsigned old = xb_add(&bar[XB_XSUB(x)], 1u);
        const unsigned gen = old / nloc;
        if (old + 1u == (gen + 1u) * nloc) {
            __builtin_amdgcn_fence(__ATOMIC_RELEASE, "agent");
            asm volatile("s_waitcnt vmcnt(0)" ::: "memory");
            const unsigned og = xb_add(&bar[XB_TOP], 1u);
            const unsigned tg = og / nx;
            if (og + 1u == (tg + 1u) * nx) xb_add(&bar[XB_TOPGEN], 1u);
            else XB_SPIN(xb_ld(&bar[XB_TOPGEN]) == tg, bar);
            __builtin_amdgcn_fence(__ATOMIC_ACQUIRE, "agent");
            xb_add(&bar[XB_XGEN(x)], 1u);
            asm volatile("s_waitcnt vmcnt(0)" ::: "memory");
        } else {
            XB_SPIN(xb_ld(&bar[XB_XGEN(x)]) == gen, bar);
            __builtin_amdgcn_fence(__ATOMIC_ACQUIRE, "agent");
            asm volatile("s_waitcnt vmcnt(0)" ::: "memory");
        }
    }
    __syncthreads();
}
#ifndef DUP_SEQ
#define DUP_SEQ 0
#endif
#if DUP_SEQ == 1
constexpr int PH_PER_LAYER = 22;
__host__ __device__ __forceinline__ int step_k(int s, int& flag) { flag = (s == 4); return s < 4 ? s : (s < 6 ? s - 2 : s - 2); }
#elif DUP_SEQ == 2
constexpr int PH_PER_LAYER = 22;
__host__ __device__ __forceinline__ int step_k(int s, int& flag) { flag = (s == 4 || s == 5); return s < 4 ? s : s - 2; }
#else
constexpr int PH_PER_LAYER = 20;
__host__ __device__ __forceinline__ int step_k(int s, int& flag) { flag = 0; return s; }
#endif
__host__ __device__ __forceinline__ bool k_nosync(int k) { return k == 5 || k == 6 || k == 7 || k == 8 || (k >= 11 && k <= 15) || k == 17; }
constexpr int LDS_BYTES = 147456, PH_TOTAL = DEPTH * PH_PER_LAYER + 1;
__global__ void __launch_bounds__(512, 2) fwd_mega(Args Aarg) {
    extern __shared__ __attribute__((aligned(16))) unsigned char lds[];
    cg::grid_group grid = cg::this_grid();
    const int G = gridDim.x;
    LAS unsigned char* ldsl = (LAS unsigned char*)lds;
    const int ph_lo = Aarg.ph_lo, ph_hi = Aarg.ph_hi;
    if (ph_lo < 0) grid.sync();
    const int wid0 = __builtin_amdgcn_readfirstlane((int)(threadIdx.x >> 6));
    if (threadIdx.x < 2) ((volatile LAS unsigned*)(ldsl + 133120))[threadIdx.x] = 0u;
    __syncthreads();
    if (threadIdx.x == 0) (void)xb_add((unsigned*)Aarg.ws + XB_XCNT(xb_xcc_id()), 1u);
    for (int ph = ph_lo; ph < ph_hi; ++ph) {
        int bid = blockIdx.x; asm volatile("" : "+s"(bid));
        AP A = (AP)__builtin_amdgcn_kernarg_segment_ptr(); asm volatile("" : "+s"(A));
        int flag; const int k = step_k(ph % PH_PER_LAYER, flag);
        { const bool nosync = (ph != PH_TOTAL - 1) && k_nosync(k);
#ifdef EXTRA_BAR
          for (int xb = 0; xb < ((ph > ph_lo && !nosync) ? 1 + EXTRA_BAR : 0); ++xb) {
#else
          if (ph > ph_lo && !nosync) {
#endif
              xcd_barrier((unsigned*)A->ws, (volatile LAS unsigned*)(ldsl + 133120), mk_tid(wid0) == 0, (unsigned)G); } }
        unsigned char* ws = A->ws; float* out = A->out; unsigned char* ob = (unsigned char*)out;
        bf16_t* H = (bf16_t*)(ws + WS_H); bf16_t* P = (bf16_t*)(ws + WS_P);
        const int l = ph / PH_PER_LAYER;
        if (ph == PH_TOTAL - 1) { const int tid = mk_tid(wid0); const int lane = tid & 63, gw = bid * 8 + (tid >> 6);
            const f32x4* gr = (const f32x4*)A->in[23] + lane;
            for (int m0 = gw * 2; m0 < MTOK; m0 += G * 16) {
                u32x2 w[2][4]; float sq[2];
#pragma unroll
                for (int i = 0; i < 2; ++i) { const u32x2* xr = (const u32x2*)(H + (size_t)(m0 + i) * DM) + lane;
#pragma unroll
                    for (int j = 0; j < 4; ++j) w[i][j] = xr[64 * j]; }
#pragma unroll
                for (int i = 0; i < 2; ++i) { float s = 0.f;
#pragma unroll
                    for (int j = 0; j < 4; ++j) { const float a = bf2f(w[i][j].x & 0xffffu), b = bf2f(w[i][j].x >> 16), c = bf2f(w[i][j].y & 0xffffu), d = bf2f(w[i][j].y >> 16); s += (a * a + b * b) + (c * c + d * d); }
                    sq[i] = rsqrtf(wave_sum(s) * (1.f / DM) + EPS); }
#pragma unroll
                for (int i = 0; i < 2; ++i) { f32x4* xr = (f32x4*)(out + (size_t)(m0 + i) * DM) + lane;
#pragma unroll
                    for (int j = 0; j < 4; ++j) { const f32x4 g4 = gr[64 * j]; f32x4 o; o.x = bf2f(w[i][j].x & 0xffffu) * sq[i] * g4.x; o.y = bf2f(w[i][j].x >> 16) * sq[i] * g4.y; o.z = bf2f(w[i][j].y & 0xffffu) * sq[i] * g4.z; o.w = bf2f(w[i][j].y >> 16) * sq[i] * g4.w; xr[64 * j] = o; } } }
            continue; }
        const float* xin = (l == 0) ? A->in[0] : out;
        pg8::StaticOrder S;
#ifdef DUP_K
        for (int rep = 0; rep < ((k == DUP_K || k == DUP_K2) ? 2 : 1); ++rep)
#endif
        switch (k) {
        case 0: phase_weights(wid0, bid, A, l, lds, G); if (l == 0) phase_xcast(wid0, bid, xin, H, (float*)(ws + WS_SSQA), G); break;
        case 1: { pg8::Gemm g{H, (const bf16_t*)(ws + WS_WIN), MTOK, 4096, DM, DM}; S.init(MTOK, 4096, G, bid);
            pg8::EpiBf16<0, 0> E{P, LDP, nullptr, 0, (const float*)(ws + WS_SSQA)}; pg8::gemm_phase(wid0, ldsl, g, S, E); } break;
        case 2: if (!flag) phase_elem(wid0, bid, P, A->in[6] + l * 384, A->in[7] + l * 256, (const float*)(ws + WS_ROPE), (bf16_t*)(ob + OB_KRP), G);
            hgrn_pass1(wid0, bid, lds, P, (const float*)(ws + WS_LBS) + l * 512, (bf16_t*)(ws + WS_HST), (float*)(ws + WS_HGD), G);
            mamba_pass1(wid0, bid, lds, P, A->in[10] + l * 4 * 768, A->in[11] + l * 768, A->in[12] + l * 8, A->in[13] + l * 8, (bf16_t*)(ws + WS_MST), (float*)(ws + WS_MAT), G); break;
        case 3: hgrn_scan(wid0, bid, (bf16_t*)(ws + WS_HST), (const float*)(ws + WS_HGD), G); mamba_scan(wid0, bid, (bf16_t*)(ws + WS_MST), (const float*)(ws + WS_MAT), G); break;
        case 4: hgrn_pass3(wid0, bid, lds, flag ? (bf16_t*)(ws + WS_VT) : P + C_YA, flag ? 512 : LDP, P, (const float*)(ws + WS_LBS) + l * 512, A->in[5] + l * 512, (const bf16_t*)(ws + WS_HST), G); break;
        case 5: mamba_pass3(wid0, bid, lds, flag ? (bf16_t*)(ws + WS_VT) : P + C_YC, flag ? 512 : LDP, P, A->in[10] + l * 4 * 768, A->in[11] + l * 768, A->in[12] + l * 8, A->in[13] + l * 8, A->in[14] + l * 8, A->in[15] + l * 512, (const bf16_t*)(ws + WS_MST), G); break;
        case 6: { pg8::Gemm g{P + C_CQ, (const bf16_t*)(ws + WS_WUQ), MTOK, 768, 384, LDP}; S.init(MTOK, 768, G, bid);
                    pg8::EpiQ E{(bf16_t*)(ob + OB_Q), (const float*)(ws + WS_ROPE)}; pg8::gemm_phase(wid0, ldsl, g, S, E); } break;
        case 7: { pg8::Gemm g{P + C_CKV, (const bf16_t*)(ws + WS_WUK), MTOK, 512, 256, LDP}; S.init(MTOK, 512, G, bid);
                    pg8::EpiBf16<0, 0> E{(bf16_t*)(ob + OB_KN), 512, nullptr, 0, nullptr}; pg8::gemm_phase(wid0, ldsl, g, S, E); } break;
        case 8: { pg8::Gemm g{P + C_CKV, (const bf16_t*)(ws + WS_WUV), MTOK, 512, 256, LDP}; S.init(MTOK, 512, G, bid);
                    pg8::EpiVT E{(bf16_t*)(ob + OB_VT)}; pg8::gemm_phase(wid0, ldsl, g, S, E); } break;
        case 9: phase_attn(wid0, bid, lds, (const bf16_t*)(ob + OB_Q), (const bf16_t*)(ob + OB_KN), (const bf16_t*)(ob + OB_KRP), (const bf16_t*)(ob + OB_VT), P, G); break;
        case 10: { S.init(MTOK, DM, G, bid);
            pg8::MergeArgs ma{H, P, (const bf16_t*)(ws + WS_WIN) + (size_t)4096 * DM, (const bf16_t*)(ws + WS_WBR)};
            pg8::EpiBf16<2, 0> EG{(bf16_t*)(ws + WS_G), DM, nullptr, 0, (const float*)(ws + WS_SSQA)};
            pg8::EpiBf16<0, 1> EB1{(bf16_t*)(ws + WS_MG), DM, (const bf16_t*)(ws + WS_G), DM, nullptr};
            pg8::EpiBf16<0, 2> EB2{(bf16_t*)(ws + WS_MG), DM, (const bf16_t*)(ws + WS_G), DM, nullptr};
            pg8::gemm_merge(wid0, ldsl, ma, S, EG, EB1, EB2); } break;
        case 11: case 12: case 13: case 14: case 15: break;
        case 16: { pg8::Gemm g{(const bf16_t*)(ws + WS_MG), (const bf16_t*)(ws + WS_WOUT), MTOK, DM, DM, DM}; S.init(MTOK, DM, G, bid);
            pg8::EpiRes E{H, (float*)(ws + WS_SSQB)}; pg8::gemm_phase(wid0, ldsl, g, S, E); } break;
        case 17: break;
        case 18: { pg8::Gemm g{H, (const bf16_t*)(ws + WS_WUP), MTOK, DFF, DM, DM}; S.init(MTOK, DFF, G, bid);
            pg8::EpiBf16<1, 0> E{P, DFF, nullptr, 0, (const float*)(ws + WS_SSQB)}; pg8::gemm_phase(wid0, ldsl, g, S, E); } break;
        case 19: { pg8::Gemm g{P, (const bf16_t*)(ws + WS_WDN), MTOK, DM, DFF, DFF}; S.init(MTOK, DM, G, bid);
            pg8::EpiRes E{H, (float*)(ws + WS_SSQA)}; pg8::gemm_phase(wid0, ldsl, g, S, E); } break;
        }
    }
}

#ifdef DBG_STOP
__global__ void dbg_dump(const unsigned char* ws, float* out) {
    const bf16_t* B0 = (const bf16_t*)(ws + DBG_B0); const bf16_t* B1 = (const bf16_t*)(ws + DBG_B1);
    for (size_t e = (size_t)blockIdx.x * 256 + threadIdx.x; e < (size_t)MTOK * DM; e += (size_t)gridDim.x * 256) { const size_t m = e >> 10; const int c = (int)(e & 1023);
        out[e] = c < 512 ? bf2f(B0[m * DBG_P0 + c]) : bf2f(B1[m * DBG_P1 + (c - 512)]); }
}
#endif
extern "C" void kernel_launch(void* const* d_in, const int* in_sizes, int n_in, void* d_out, int out_size, void* d_ws, size_t ws_size, hipStream_t stream) {
    static int grid = 0;
    if (grid == 0) {
        if (n_in != 24 || out_size != MTOK * DM || ws_size < WS_END) { fprintf(stderr, "kernel_launch: unexpected shapes (n_in %d out %d ws %zu)\n", n_in, out_size, ws_size); grid = -1; return; }
        int dev = 0, cus = 0, per_cu = 0;
        hipGetDevice(&dev); hipDeviceGetAttribute(&cus, hipDeviceAttributeMultiprocessorCount, dev);
        hipFuncSetAttribute((const void*)fwd_mega, hipFuncAttributeMaxDynamicSharedMemorySize, LDS_BYTES);
        hipOccupancyMaxActiveBlocksPerMultiprocessor(&per_cu, (const void*)fwd_mega, 512, LDS_BYTES);
        (void)hipGetLastError();
        grid = (per_cu >= 1) ? cus : -1;
        if (grid < 0) { fprintf(stderr, "kernel_launch: occupancy query says 0 blocks/CU\n"); return; }
    }
    if (grid < 0) return;
    if (hipMemsetAsync(d_ws, 0, 16384, stream) != hipSuccess) { fprintf(stderr, "memset failed\n"); return; }
    Args a{};
    for (int i = 0; i < 24; ++i) a.in[i] = (const float*)d_in[i];
    a.out = (float*)d_out; a.ws = (unsigned char*)d_ws; a.ph_lo = 0; a.ph_hi = PH_TOTAL;
#ifndef MULTI_LAUNCH
#define MULTI_LAUNCH 0
#endif
#if MULTI_LAUNCH
#ifdef DBG_STOP
    const int PH_END = DBG_STOP;
#else
    const int PH_END = PH_TOTAL;
#endif
    for (int lo = 0; lo < PH_END; ) {
        int hi = lo + 1;

        while (hi < PH_TOTAL - 1) { int fl; if (k_nosync(step_k(hi % PH_PER_LAYER, fl))) ++hi; else break; }
        a.ph_lo = lo; a.ph_hi = hi;
        hipLaunchKernelGGL(fwd_mega, dim3(grid), dim3(512), LDS_BYTES, stream, a);
        lo = hi;
    }
#ifdef DBG_STOP
    hipLaunchKernelGGL(dbg_dump, dim3(2048), dim3(256), 0, stream, (const unsigned char*)d_ws, (float*)d_out);
#endif
#else
    void* args[] = {&a};
    hipError_t e = hipLaunchCooperativeKernel((const void*)fwd_mega, dim3(grid), dim3(512), args, LDS_BYTES, stream);
    if (e != hipSuccess) fprintf(stderr, "cooperative launch failed: %s (grid %d)\n", hipGetErrorString(e), grid);
#endif
}
```
